# Optimizing an MI355X kernel written in HIP

```python
import math
import jax, jax.numpy as jnp
from jax import lax
import numpy as np

D_MODEL = 1024
BATCH = 1
SEQ = 16384
DEPTH = 4

D_MIX = D_MODEL
HEAD_DIM = 64
D_M = D_MIX // 4
M_HEADS = D_M // HEAD_DIM
M_CHUNK = 64
D_A = D_MIX // 4
A_HEADS = D_A // HEAD_DIM
IDX_HEADS = 4
IDX_DIM = 64
TOPK_MAX = 256
Q_BLOCK = 128
D_S = D_MIX // 2
S_HEADS = D_S // HEAD_DIM
S_GROUPS = 2
S_STATE = 128
S_CONV = 4
S_CHUNK = 64
CONV_DIM = D_S + 2 * S_GROUPS * S_STATE
ROPE_THETA = 500000.0
ROPE_DIM = HEAD_DIM // 4
D_FF = -(-8 * D_MODEL // (3 * 256)) * 256
EPS = 1e-6
N_IN = (4 * D_M + 2 * M_HEADS) + (3 * D_A + IDX_HEADS * IDX_DIM + IDX_DIM + IDX_HEADS) + (D_S + CONV_DIM + S_HEADS)

kernel_name = "hymba_style_mlstm_dsa_ssd_hybrid"


def _split_points():
    sizes = (D_M, D_M, D_M, D_M, M_HEADS, M_HEADS,
             D_A, D_A, D_A, IDX_HEADS * IDX_DIM, IDX_DIM, IDX_HEADS,
             D_S, CONV_DIM, S_HEADS)
    return [int(v) for v in np.cumsum(sizes)[:-1]]


def rms_norm(x, w):
    xf = x.astype(jnp.float32)
    y = xf * lax.rsqrt(jnp.mean(xf * xf, axis=-1, keepdims=True) + EPS)
    return (y * w.astype(jnp.float32)).astype(x.dtype)


def rope_partial(x, positions):
    half = ROPE_DIM // 2
    inv_freq = jnp.power(jnp.float32(ROPE_THETA), -jnp.arange(half, dtype=jnp.float32) / half)
    ang = positions.astype(jnp.float32)[..., None] * inv_freq
    cos = jnp.cos(ang)[:, :, None, :]
    sin = jnp.sin(ang)[:, :, None, :]
    x1 = x[..., :half].astype(jnp.float32)
    x2 = x[..., half:ROPE_DIM].astype(jnp.float32)
    rot = jnp.concatenate([x1 * cos - x2 * sin, x2 * cos + x1 * sin], axis=-1).astype(x.dtype)
    return jnp.concatenate([rot, x[..., ROPE_DIM:]], axis=-1)


def mlstm_chunkwise(q, k, v, i_pre, f_pre):
    B, S, H, d = q.shape
    L = M_CHUNK
    nc = S // L
    f32 = jnp.float32

    def to_chunks(t):
        t = t.reshape(B, nc, L, H, *t.shape[3:])
        return jnp.moveaxis(t, (1, 3), (0, 2))

    qc = to_chunks(q.astype(f32) * (d ** -0.5))
    kc = to_chunks(k.astype(f32))
    vc = to_chunks(v.astype(f32))
    ic = to_chunks(i_pre.astype(f32))
    lfc = to_chunks(jax.nn.log_sigmoid(f_pre.astype(f32)))
    causal = jnp.tril(jnp.ones((L, L), dtype=bool))

    def step(carry, inp):
        C, n, m = carry
        qb, kb, vb, ib, lfb = inp
        b = jnp.cumsum(lfb, axis=-1)
        log_d = jnp.where(causal, b[..., :, None] - b[..., None, :] + ib[..., None, :], -jnp.inf)
        m_inter = b + m[..., None]
        m_t = jnp.maximum(m_inter, jnp.max(log_d, axis=-1))
        s = jnp.einsum('bhtd,bhsd->bhts', qb, kb) * jnp.exp(log_d - m_t[..., None])
        scale = jnp.exp(m_inter - m_t)
        num = (jnp.einsum('bhts,bhsd->bhtd', s, vb)
               + scale[..., None] * jnp.einsum('bhtd,bhde->bhte', qb, C))
        den = jnp.sum(s, axis=-1) + scale * jnp.einsum('bhtd,bhd->bht', qb, n)
        h = num / jnp.maximum(jnp.abs(den), jnp.exp(-m_t))[..., None]
        b_last = b[..., -1]
        log_w = b_last[..., None] - b + ib
        m_new = jnp.maximum(b_last + m, jnp.max(log_w, axis=-1))
        w = jnp.exp(log_w - m_new[..., None])
        decay = jnp.exp(b_last + m - m_new)
        C_new = decay[..., None, None] * C + jnp.einsum('bhs,bhsd,bhse->bhde', w, kb, vb)
        n_new = decay[..., None] * n + jnp.einsum('bhs,bhsd->bhd', w, kb)
        return (C_new, n_new, m_new), h

    init = (jnp.zeros((B, H, d, d), f32), jnp.zeros((B, H, d), f32), jnp.zeros((B, H), f32))
    _, hc = lax.scan(step, init, (qc, kc, vc, ic, lfc))
    return jnp.moveaxis(hc, (0, 2), (1, 3)).reshape(B, S, H, d)


def dsa_attention(q, k, v, q_idx, k_idx, w_idx):
    B, S, H, d = q.shape
    top_k = min(TOPK_MAX, S // 4)
    nb = S // Q_BLOCK
    f32 = jnp.float32
    key_pos = jnp.arange(S)
    k_idx_f = k_idx.astype(f32)

    def blocks(t):
        return jnp.moveaxis(t.reshape(B, nb, Q_BLOCK, *t.shape[2:]), 1, 0)

    def one_block(inp):
        qb, qib, wb, qpos = inp
        dots = jnp.einsum('bthd,bsd->bths', qib.astype(f32), k_idx_f) * (IDX_DIM ** -0.5)
        score = jnp.einsum('bth,bths->bts', wb.astype(f32), jax.nn.relu(dots))
        causal = key_pos[None, :] <= qpos[:, None]
        score = jnp.where(causal[None], score, -jnp.inf)
        _, sel = lax.top_k(score, top_k)
        valid = sel <= qpos[None, :, None]
        k_sel = jax.vmap(lambda kk, ii: kk[ii])(k, sel)
        v_sel = jax.vmap(lambda vv, ii: vv[ii])(v, sel)
        logits = jnp.einsum('bthd,btkhd->bthk', qb.astype(f32), k_sel.astype(f32)) * (d ** -0.5)
        logits = jnp.where(valid[:, :, None, :], logits, -jnp.inf)
        p = jax.nn.softmax(logits, axis=-1)
        return jnp.einsum('bthk,btkhd->bthd', p, v_sel.astype(f32))

    out = lax.map(one_block, (blocks(q), blocks(q_idx), blocks(w_idx),
                              jnp.arange(S).reshape(nb, Q_BLOCK)))
    return jnp.moveaxis(out, 0, 1).reshape(B, S, H, d)


def ssd_chunked(x, dt, A, Bh, Ch):
    B, S, H, P = x.shape
    N = Bh.shape[-1]
    L = S_CHUNK
    nc = S // L

    def to_chunks(t):
        return jnp.moveaxis(t.reshape(B, nc, L, *t.shape[2:]), 1, 0)

    causal = jnp.tril(jnp.ones((L, L), dtype=bool))

    def step(state, inp):
        xb, dtb, Bb, Cb = inp
        acum = jnp.cumsum(dtb * A, axis=1)
        seg = jnp.where(causal[None, :, :, None], acum[:, :, None, :] - acum[:, None, :, :], -jnp.inf)
        scores = jnp.einsum('bthn,bshn->btsh', Cb, Bb) * jnp.exp(seg)
        y_intra = jnp.einsum('btsh,bshp->bthp', scores, xb * dtb[..., None])
        y_inter = jnp.einsum('bthn,bhpn->bthp', Cb, state) * jnp.exp(acum)[..., None]
        a_last = acum[:, -1]
        w = jnp.exp(a_last[:, None, :] - acum) * dtb
        state_new = (state * jnp.exp(a_last)[..., None, None]
                     + jnp.einsum('bshn,bsh,bshp->bhpn', Bb, w, xb))
        return state_new, y_intra + y_inter

    init = jnp.zeros((B, H, P, N), jnp.float32)
    _, yc = lax.scan(step, init, (to_chunks(x), to_chunks(dt), to_chunks(Bh), to_chunks(Ch)))
    return jnp.moveaxis(yc, 0, 1).reshape(B, S, H, P)


def ssd_mixer(xbc_raw, z, dt_raw, conv_w, conv_b, dt_bias, a_log, d_skip, norm_w):
    B, S, _ = xbc_raw.shape
    f32 = jnp.float32
    xbc = lax.conv_general_dilated(
        xbc_raw, conv_w[:, None, :], window_strides=(1,), padding=[(S_CONV - 1, 0)],
        dimension_numbers=('NWC', 'WIO', 'NWC'), feature_group_count=CONV_DIM) + conv_b
    xbc = jax.nn.silu(xbc.astype(f32))
    xs, Bm, Cm = jnp.split(xbc, [D_S, D_S + S_GROUPS * S_STATE], axis=-1)
    xs = xs.reshape(B, S, S_HEADS, HEAD_DIM)
    rep = S_HEADS // S_GROUPS
    Bh = jnp.repeat(Bm.reshape(B, S, S_GROUPS, S_STATE), rep, axis=2)
    Ch = jnp.repeat(Cm.reshape(B, S, S_GROUPS, S_STATE), rep, axis=2)
    dt = jax.nn.softplus(dt_raw.astype(f32) + dt_bias.astype(f32))
    A = -jnp.exp(a_log.astype(f32))
    y = ssd_chunked(xs, dt, A, Bh, Ch) + d_skip.astype(f32)[:, None] * xs
    gated = y.reshape(B, S, D_S) * jax.nn.silu(z.astype(f32))
    out = rms_norm(gated.reshape(B, S, S_GROUPS, D_S // S_GROUPS), norm_w.reshape(S_GROUPS, -1))
    return out.reshape(B, S, D_S)


def hybrid_layer(x, positions, norm_w, w_in, gate_b, m_norm_w, conv_w, conv_b,
                 dt_bias, a_log, d_skip, s_norm_w, w_out, w_gate, w_up, w_down):
    B, S, _ = x.shape
    h = rms_norm(x, norm_w[0])
    proj = h @ w_in
    (mq, mk, mv, mo, mi, mf, aq, ak, av, iq, ik, iw, sz, sxbc, sdt) = jnp.split(proj, _split_points(), axis=-1)

    def heads(t, n):
        return t.reshape(B, S, n, -1)

    hm = mlstm_chunkwise(heads(mq, M_HEADS), heads(mk, M_HEADS), heads(mv, M_HEADS),
                         mi + gate_b[:M_HEADS], mf + gate_b[M_HEADS:])
    hm = rms_norm(hm, m_norm_w.reshape(M_HEADS, HEAD_DIM)).reshape(B, S, D_M)
    hm = (jax.nn.sigmoid(mo.astype(jnp.float32)) * hm).astype(x.dtype)

    aq_r = rope_partial(heads(aq, A_HEADS), positions)
    ak_r = rope_partial(heads(ak, A_HEADS), positions)
    iq_r = rope_partial(heads(iq, IDX_HEADS), positions)
    ik_r = rope_partial(ik[:, :, None, :], positions)[:, :, 0, :]
    ha = dsa_attention(aq_r, ak_r, heads(av, A_HEADS), iq_r, ik_r, iw * (IDX_HEADS ** -0.5))
    ha = ha.reshape(B, S, D_A).astype(x.dtype)

    hs = ssd_mixer(sxbc, sz, sdt, conv_w, conv_b, dt_bias, a_log, d_skip, s_norm_w).astype(x.dtype)

    mix = jnp.concatenate([hm, ha, hs], axis=-1) @ w_out
    x = x + rms_norm(mix, norm_w[1])
    h = rms_norm(x, norm_w[2])
    ff = (jax.nn.silu(h @ w_gate) * (h @ w_up)) @ w_down
    return x + rms_norm(ff, norm_w[3])


def setup_inputs(seed: int = 0) -> dict:
    key = jax.random.key(seed)
    ks = jax.random.split(key, 18)
    f32 = jnp.float32
    nrm = lambda k, shape, s: jax.random.normal(k, shape, f32) * s
    x = jax.random.normal(ks[0], (BATCH, SEQ, D_MODEL), f32)
    positions = jnp.broadcast_to(jnp.arange(SEQ, dtype=jnp.int32), (BATCH, SEQ))
    norm_w = 1.0 + nrm(ks[1], (DEPTH, 4, D_MODEL), 0.02)
    w_in = nrm(ks[2], (DEPTH, D_MODEL, N_IN), D_MODEL ** -0.5)
    i_bias = nrm(ks[3], (DEPTH, M_HEADS), 0.1)
    f_bias = jax.random.uniform(ks[4], (DEPTH, M_HEADS), f32, 3.0, 6.0)
    mlstm_gate_bias = jnp.concatenate([i_bias, f_bias], axis=-1)
    mlstm_norm_w = 1.0 + nrm(ks[5], (DEPTH, D_M), 0.02)
    conv_w = nrm(ks[6], (DEPTH, S_CONV, CONV_DIM), S_CONV ** -0.5)
    conv_b = nrm(ks[7], (DEPTH, CONV_DIM), 0.02)
    dt0 = jnp.exp(jax.random.uniform(ks[8], (DEPTH, S_HEADS), f32, math.log(1e-3), math.log(1e-1)))
    dt_bias = dt0 + jnp.log(-jnp.expm1(-dt0))
    a_log = jnp.log(jax.random.uniform(ks[9], (DEPTH, S_HEADS), f32, 1.0, 16.0))
    d_skip = 1.0 + nrm(ks[10], (DEPTH, S_HEADS), 0.1)
    ssd_norm_w = 1.0 + nrm(ks[11], (DEPTH, D_S), 0.02)
    w_out = nrm(ks[12], (DEPTH, D_MIX, D_MODEL), D_MIX ** -0.5)
    w_gate = nrm(ks[13], (DEPTH, D_MODEL, D_FF), D_MODEL ** -0.5)
    w_up = nrm(ks[14], (DEPTH, D_MODEL, D_FF), D_MODEL ** -0.5)
    w_down = nrm(ks[15], (DEPTH, D_FF, D_MODEL), D_FF ** -0.5)
    return {"x": x, "positions": positions, "norm_w": norm_w, "w_in": w_in,
            "mlstm_gate_bias": mlstm_gate_bias, "mlstm_norm_w": mlstm_norm_w,
            "conv_w": conv_w, "conv_b": conv_b, "dt_bias": dt_bias, "a_log": a_log,
            "d_skip": d_skip, "ssd_norm_w": ssd_norm_w, "w_out": w_out,
            "w_gate": w_gate, "w_up": w_up, "w_down": w_down}


def reference(x, positions, norm_w, w_in, mlstm_gate_bias, mlstm_norm_w, conv_w, conv_b,
              dt_bias, a_log, d_skip, ssd_norm_w, w_out, w_gate, w_up, w_down):
    for l in range(DEPTH):
        x = hybrid_layer(x, positions, norm_w[l], w_in[l], mlstm_gate_bias[l], mlstm_norm_w[l],
                         conv_w[l], conv_b[l], dt_bias[l], a_log[l], d_skip[l], ssd_norm_w[l],
                         w_out[l], w_gate[l], w_up[l], w_down[l])
    return x
```

```cpp
#include <hip/hip_runtime.h>
#include <hip/hip_cooperative_groups.h>
#include <cstdio>
#include <cstdint>
namespace cg = cooperative_groups;

#ifndef MK_MULTI
#define MK_MULTI 1
#endif

namespace pg8 {
#define PG8_LAS __attribute__((address_space(3)))
typedef unsigned short bf16_t;
typedef short bf16x8 __attribute__((ext_vector_type(8)));
typedef float f32x4 __attribute__((ext_vector_type(4)));
typedef unsigned u32x4 __attribute__((ext_vector_type(4)));
constexpr int BM = 256, BK = 64, HALF = 128, HTB = HALF * BK * 2  , STAGE_BYTES = 8 * HTB, NXCD = 8, WGM = 8;

__host__ __device__ __forceinline__ int lds_byte(int r, int c) { const int st = (r >> 4) * 2 + (c >> 5), rr = r & 15, cc = c & 31, ob = rr * 64 + cc * 2; return st * 1024 + (ob ^ (((ob >> 9) & 1) << 5)); }
__host__ __device__ __forceinline__ void stage_rc(int b, int& R, int& C) { const int st = b / 1024, sb = b % 1024, swz = sb ^ (((sb >> 9) & 1) << 5); R = (st >> 1) * 16 + swz / 64; C = (st & 1) * 32 + (swz % 64) / 2; }
__host__ __device__ __forceinline__ int perm32(int rho) { const int n = rho >> 4, i = rho & 15; return 8 * (i >> 2) + 4 * n + (i & 3); }

struct Unit { int pm, pn; };
struct Gemm { const bf16_t* A; const bf16_t* Bt; int M, N, K; };

struct StaticOrder {
    int nM, nN, nwg, G, c;
    __host__ __device__ void init(int M, int N, int G_, int c_) { nM = M / BM; nN = N / BM; nwg = nM * nN; G = G_; c = c_; }
    __host__ __device__ bool next(int i, Unit& u) const {
        const long L = (long)i * G + c; if (L >= nwg) return false;
        int wgid = (int)L; { const int q = nwg / NXCD, r = nwg % NXCD, xcd = wgid % NXCD, off = wgid / NXCD; wgid = (xcd < r ? xcd * (q + 1) : r * (q + 1) + (xcd - r) * q) + off; }
        const int nig = WGM * nN, gid = wgid / nig, fm = gid * WGM, gsz = (nM - fm) < WGM ? (nM - fm) : WGM;
        u.pm = fm + ((wgid % nig) % gsz); u.pn = (wgid % nig) / gsz; return true;
    }
    __device__ __forceinline__ void a_ready(const Unit&) const {}
    __device__ __forceinline__ void done(const Unit&) const {}
};


__device__ __forceinline__ unsigned cvt_pk_bf16(float lo, float hi) { unsigned r; asm volatile("v_cvt_pk_bf16_f32 %0, %1, %2" : "=v"(r) : "v"(lo), "v"(hi)); return r; }

struct EpiF32 {
    static constexpr bool PERM = false, AFTER_DRAIN = false;
    float* O; int ldc;
    __device__ __forceinline__ void operator()(const f32x4 (&acc)[2][2][4][2], const Unit& u, int wr, int wc, int fr, int fq) const {
        const int row0 = u.pm * BM + wr * 64 + fr, col0 = u.pn * BM + wc * 32 + 4 * fq;
#pragma unroll
        for (int ai = 0; ai < 2; ++ai)
#pragma unroll
            for (int m = 0; m < 4; ++m) { float* rowp = O + (size_t)(row0 + ai * HALF + m * 16) * ldc + col0;
#pragma unroll
                for (int bj = 0; bj < 2; ++bj)
#pragma unroll
                    for (int n = 0; n < 2; ++n) *(f32x4*)(rowp + bj * HALF + n * 16) = acc[ai][bj][m][n]; }
    }
};

__device__ __forceinline__ float silu_f(float g) { return g * __builtin_amdgcn_rcpf(1.0f + __expf(-g)); }

struct EpiSwiGLU {
    static constexpr bool PERM = true, AFTER_DRAIN = false;
    bf16_t* O; int ldc;
    __device__ __forceinline__ void operator()(const f32x4 (&acc)[2][2][4][2], const Unit& u, int wr, int wc, int fr, int fq) const {
        const int row0 = u.pm * BM + wr * 64 + fr, col0 = u.pn * HALF + wc * 32 + 8 * fq;
#pragma unroll
        for (int ai = 0; ai < 2; ++ai)
#pragma unroll
            for (int m = 0; m < 4; ++m) {
                const f32x4 g0 = acc[ai][0][m][0], g1 = acc[ai][0][m][1], u0 = acc[ai][1][m][0], u1 = acc[ai][1][m][1];
                u32x4 w;
                w.x = cvt_pk_bf16(silu_f(g0[0]) * u0[0], silu_f(g0[1]) * u0[1]); w.y = cvt_pk_bf16(silu_f(g0[2]) * u0[2], silu_f(g0[3]) * u0[3]);
                w.z = cvt_pk_bf16(silu_f(g1[0]) * u1[0], silu_f(g1[1]) * u1[1]); w.w = cvt_pk_bf16(silu_f(g1[2]) * u1[2], silu_f(g1[3]) * u1[3]);
                *(u32x4*)(O + (size_t)(row0 + ai * HALF + m * 16) * ldc + col0) = w; }
    }
};

struct EpiProj {
    static constexpr bool PERM = true, AFTER_DRAIN = false;
    bf16_t* P; int ldc; float* gates; const float* cs;
    __device__ __forceinline__ void operator()(const f32x4 (&acc)[2][2][4][2], const Unit& u, int wr, int wc, int fr, int fq) const {
        const int row0 = u.pm * BM + wr * 64 + fr, pn = u.pn;
        const bool ropeT = (pn == 4 || pn == 5 || pn == 7);
        const float sg = (fq == 0) ? -1.0f : 1.0f;
#pragma unroll
        for (int ai = 0; ai < 2; ++ai)
#pragma unroll
            for (int m = 0; m < 4; ++m) {
                const int row = row0 + ai * HALF + m * 16;
#pragma unroll
                for (int bj = 0; bj < 2; ++bj) {
                    f32x4 v0 = acc[ai][bj][m][0], v1 = acc[ai][bj][m][1];
                    const bool rope = ((wc & 1) == 0) && (ropeT || (pn == 14 && bj == 0 && wc == 0));
                    if (rope) {
                        f32x4 p0, p1;
#pragma unroll
                        for (int i = 0; i < 4; ++i) { p0[i] = __shfl_xor(v0[i], 16); p1[i] = __shfl_xor(v1[i], 16); }
                        const f32x4 c0 = *(const f32x4*)(cs + (size_t)row * 16), c1 = *(const f32x4*)(cs + (size_t)row * 16 + 4);
                        const f32x4 s0 = *(const f32x4*)(cs + (size_t)row * 16 + 8), s1 = *(const f32x4*)(cs + (size_t)row * 16 + 12);
                        if (fq < 2) { v0 = v0 * c0 + sg * (p0 * s0); v1 = v1 * c1 + sg * (p1 * s1); }
                    }
                    u32x4 w; w.x = cvt_pk_bf16(v0[0], v0[1]); w.y = cvt_pk_bf16(v0[2], v0[3]); w.z = cvt_pk_bf16(v1[0], v1[1]); w.w = cvt_pk_bf16(v1[2], v1[3]);
                    *(u32x4*)(P + (size_t)row * ldc + pn * BM + bj * HALF + wc * 32 + 8 * fq) = w;
                    if (pn == 14 && bj == 0 && wc == 2) { *(f32x4*)(gates + (size_t)row * 32 + 8 * fq) = v0; *(f32x4*)(gates + (size_t)row * 32 + 8 * fq + 4) = v1; }
                }
            }
    }
};

template <class Epi, class Sched, bool ALIGN_EPI = false, bool SP2 = false>
__device__ __forceinline__ void gemm_phase(PG8_LAS unsigned char* lds, const Gemm g, const Sched& S, const Epi& E) {
    int tid_ = threadIdx.x; asm volatile("" : "+v"(tid_));
    const int tid = tid_, wid = __builtin_amdgcn_readfirstlane(tid >> 6), lane = tid & 63, wr = wid >> 2, wc = wid & 3, fr = lane & 15, fq = lane >> 4;
    const int K = g.K, nt = K / BK;
    unsigned voffA[2], voffB[2];
#pragma unroll
    for (int i = 0; i < 2; ++i) { int R, C; stage_rc(tid * 16 + i * 8192, R, C); const int Rb = Epi::PERM ? ((R & ~31) + perm32(R & 31)) : R;
        voffA[i] = (unsigned)(R * K + C) * 2u; voffB[i] = (unsigned)(Rb * K + C) * 2u; }
    const size_t kstep = (size_t)(BK * 2);
    const size_t hstep = (size_t)HALF * K * 2;
    const size_t tstep = 2 * hstep;
    const unsigned ldsw = (unsigned)wid * 1024u;
    const int aoff = lds_byte(wr * 64 + fr, fq * 8), boff = lds_byte(wc * 32 + fr, fq * 8);
#define PG8_SA(b, h) (((b) * 2 + (h)) * HTB)
#define PG8_SB(b, h) ((4 + (b) * 2 + (h)) * HTB)
#define PG8_STAGE(bufoff, gbase, voff) do { _Pragma("unroll") for (int _i = 0; _i < 2; ++_i) \
        __builtin_amdgcn_global_load_lds((const unsigned*)((const char*)(gbase) + (voff)[_i]), (PG8_LAS unsigned*)(lds + (bufoff) + ldsw + _i * 8192), 16, 0, 0); } while (0)
#define PG8_LDA(dst, b, h) do { _Pragma("unroll") for (int m = 0; m < 4; ++m) _Pragma("unroll") for (int k = 0; k < 2; ++k) dst[m][k] = *(const PG8_LAS bf16x8*)(lds + PG8_SA(b, h) + aoff + m * 2048 + k * 1024); } while (0)
#define PG8_LDB(dst, b, h) do { _Pragma("unroll") for (int n = 0; n < 2; ++n) _Pragma("unroll") for (int k = 0; k < 2; ++k) dst[n][k] = *(const PG8_LAS bf16x8*)(lds + PG8_SB(b, h) + boff + n * 2048 + k * 1024); } while (0)
#define PG8_MMA(ai, bj, At, Bt) do { __builtin_amdgcn_s_setprio(1); _Pragma("unroll") for (int m = 0; m < 4; ++m) _Pragma("unroll") for (int n = 0; n < 2; ++n) _Pragma("unroll") for (int k = 0; k < 2; ++k) \
        acc[ai][bj][m][n] = __builtin_amdgcn_mfma_f32_16x16x32_bf16(Bt[n][k], At[m][k], acc[ai][bj][m][n], 0, 0, 0); __builtin_amdgcn_s_setprio(0); } while (0)
#define PG8_WAIT_V(n) asm volatile("s_waitcnt vmcnt(" #n ")" ::: "memory")
#define PG8_WAIT_L(n) asm volatile("s_waitcnt lgkmcnt(" #n ")" ::: "memory")
#define PG8_BAR __builtin_amdgcn_s_barrier()
#define PG8_SCHED __builtin_amdgcn_sched_barrier(0)
    Unit cur, nxt; int ui = 0;
    if (!S.next(0, cur)) return;
    f32x4 acc[2][2][4][2];
#pragma unroll
    for (int a = 0; a < 2; ++a)
#pragma unroll
        for (int b = 0; b < 2; ++b)
#pragma unroll
            for (int m = 0; m < 4; ++m)
#pragma unroll
                for (int n = 0; n < 2; ++n) acc[a][b][m][n] = (f32x4){0.f, 0.f, 0.f, 0.f};
    bf16x8 At[4][2], B0[2][2], B1[2][2];
    const char* cA = (const char*)g.A + (size_t)cur.pm * tstep; const char* cB = (const char*)g.Bt + (size_t)cur.pn * tstep;
    S.a_ready(cur);
    if constexpr (SP2) {
        PG8_STAGE(PG8_SB(0, 0), cB, voffB); PG8_STAGE(PG8_SB(0, 1), cB + hstep, voffB); PG8_STAGE(PG8_SA(0, 0), cA, voffA); PG8_STAGE(PG8_SA(0, 1), cA + hstep, voffA);
        if (wr == 1) PG8_BAR;
        PG8_WAIT_V(2); PG8_BAR;
        PG8_STAGE(PG8_SB(1, 0), cB + kstep, voffB); PG8_STAGE(PG8_SA(1, 0), cA + kstep, voffA); PG8_STAGE(PG8_SB(1, 1), cB + hstep + kstep, voffB);
        PG8_WAIT_V(6); PG8_BAR;
    } else {
        PG8_STAGE(PG8_SB(0, 0), cB, voffB); PG8_STAGE(PG8_SA(0, 0), cA, voffA); PG8_STAGE(PG8_SB(0, 1), cB + hstep, voffB); PG8_STAGE(PG8_SA(0, 1), cA + hstep, voffA);
        if (wr == 1) PG8_BAR;
        PG8_WAIT_V(4); PG8_BAR;
        PG8_STAGE(PG8_SB(1, 0), cB + kstep, voffB); PG8_STAGE(PG8_SA(1, 0), cA + kstep, voffA); PG8_STAGE(PG8_SB(1, 1), cB + hstep + kstep, voffB);
        PG8_WAIT_V(6); PG8_BAR;
    }
    for (;;) {
        const bool has_next = S.next(ui + 1, nxt);
        const char* nA = has_next ? (const char*)g.A + (size_t)nxt.pm * tstep : cA; const char* nB = has_next ? (const char*)g.Bt + (size_t)nxt.pn * tstep : cB;
        for (int t = 0; t < nt; t += 2) {
            const bool last = (t == nt - 2);
            const char* a1 = cA + (size_t)(t + 1) * kstep;
            const char* a2 = last ? nA : cA + (size_t)(t + 2) * kstep; const char* b2 = last ? nB : cB + (size_t)(t + 2) * kstep;
            const char* a3 = a2 + kstep; const char* b3 = b2 + kstep;
            if (last && has_next) S.a_ready(nxt);
            if constexpr (SP2) {
            PG8_LDB(B0, 0, 0); PG8_LDB(B1, 0, 1); PG8_SCHED; PG8_LDA(At, 0, 0); PG8_STAGE(PG8_SA(1, 1), a1 + hstep, voffA);
            PG8_WAIT_V(8); PG8_WAIT_L(0); PG8_BAR; PG8_MMA(0, 0, At, B0); PG8_MMA(0, 1, At, B1); PG8_BAR; PG8_SCHED;
            PG8_LDA(At, 0, 1); PG8_STAGE(PG8_SB(0, 0), b2, voffB); PG8_STAGE(PG8_SB(0, 1), b2 + hstep, voffB); PG8_STAGE(PG8_SA(0, 0), a2, voffA);
            PG8_WAIT_V(8); PG8_WAIT_L(0); PG8_BAR; PG8_MMA(1, 0, At, B0); PG8_MMA(1, 1, At, B1); PG8_BAR; PG8_SCHED;
            PG8_LDB(B0, 1, 0); PG8_LDB(B1, 1, 1); PG8_SCHED; PG8_LDA(At, 1, 0); PG8_STAGE(PG8_SA(0, 1), a2 + hstep, voffA);
            PG8_WAIT_V(8); PG8_WAIT_L(0); PG8_BAR; PG8_MMA(0, 0, At, B0); PG8_MMA(0, 1, At, B1); PG8_BAR; PG8_SCHED;
            PG8_LDA(At, 1, 1); PG8_STAGE(PG8_SB(1, 0), b3, voffB); PG8_STAGE(PG8_SB(1, 1), b3 + hstep, voffB); PG8_STAGE(PG8_SA(1, 0), a3, voffA);
            PG8_WAIT_V(8); PG8_WAIT_L(0); PG8_BAR; PG8_MMA(1, 0, At, B0); PG8_MMA(1, 1, At, B1); PG8_BAR; PG8_SCHED;
            } else {
            PG8_LDB(B0, 0, 0); PG8_SCHED; PG8_LDA(At, 0, 0); PG8_STAGE(PG8_SA(1, 1), a1 + hstep, voffA);
            PG8_WAIT_L(8); PG8_BAR; PG8_WAIT_L(0); PG8_MMA(0, 0, At, B0); PG8_BAR; PG8_SCHED;
            PG8_LDB(B1, 0, 1); PG8_STAGE(PG8_SB(0, 0), b2, voffB);
            PG8_BAR; PG8_WAIT_L(0); PG8_MMA(0, 1, At, B1); PG8_BAR;
            PG8_LDA(At, 0, 1); PG8_STAGE(PG8_SA(0, 0), a2, voffA);
            PG8_BAR; PG8_WAIT_L(0); PG8_MMA(1, 0, At, B0); PG8_BAR; PG8_SCHED;
            PG8_STAGE(PG8_SB(0, 1), b2 + hstep, voffB);
            PG8_WAIT_V(6); PG8_BAR; PG8_MMA(1, 1, At, B1); PG8_BAR;
            PG8_LDB(B0, 1, 0); PG8_SCHED; PG8_LDA(At, 1, 0); PG8_STAGE(PG8_SA(0, 1), a2 + hstep, voffA);
            PG8_WAIT_L(8); PG8_BAR; PG8_WAIT_L(0); PG8_MMA(0, 0, At, B0); PG8_BAR; PG8_SCHED;
            PG8_LDB(B1, 1, 1); PG8_STAGE(PG8_SB(1, 0), b3, voffB);
            PG8_BAR; PG8_WAIT_L(0); PG8_MMA(0, 1, At, B1); PG8_BAR;
            PG8_LDA(At, 1, 1); PG8_STAGE(PG8_SA(1, 0), a3, voffA);
            PG8_BAR; PG8_WAIT_L(0); PG8_MMA(1, 0, At, B0); PG8_BAR; PG8_SCHED;
            PG8_STAGE(PG8_SB(1, 1), b3 + hstep, voffB);
            PG8_WAIT_V(6); PG8_BAR; PG8_MMA(1, 1, At, B1); PG8_BAR;
            }
        }
        if constexpr (ALIGN_EPI) { if (wr == 0) PG8_BAR; }
        if constexpr (!Epi::AFTER_DRAIN) { E(acc, cur, wr, wc, fr, fq); S.done(cur); }
        if (!has_next) break;
#pragma unroll
        for (int a = 0; a < 2; ++a)
#pragma unroll
            for (int b = 0; b < 2; ++b)
#pragma unroll
                for (int m = 0; m < 4; ++m)
#pragma unroll
                    for (int n = 0; n < 2; ++n) acc[a][b][m][n] = (f32x4){0.f, 0.f, 0.f, 0.f};
        cur = nxt; cA = nA; cB = nB; ++ui;
        if constexpr (ALIGN_EPI) { if (wr == 1) PG8_BAR; }
    }
    PG8_WAIT_V(0);
    if constexpr (!ALIGN_EPI) { if (wr == 0) PG8_BAR; }
    PG8_BAR;
    if constexpr (Epi::AFTER_DRAIN) { E.fused(acc, cur, wr, wc, fr, fq, lds, wid, lane); S.done(cur); }
#undef PG8_SA
#undef PG8_SB
#undef PG8_STAGE
#undef PG8_LDA
#undef PG8_LDB
#undef PG8_MMA
#undef PG8_WAIT_V
#undef PG8_WAIT_L
#undef PG8_BAR
#undef PG8_SCHED
}
}

#define LAS __attribute__((address_space(3)))
typedef unsigned short bf16_t;
typedef short bf16x8 __attribute__((ext_vector_type(8)));
typedef float f32x4 __attribute__((ext_vector_type(4)));
typedef unsigned u32x4 __attribute__((ext_vector_type(4)));
typedef unsigned u32x2 __attribute__((ext_vector_type(2)));

constexpr int SEQ = 16384, DM = 1024, LDP = 3840, DFF = 2816, NLAYER = 4, NIN = 3668;
constexpr int NWAVES = 8, NTHR = 512;
constexpr float EPSN = 1e-6f;
constexpr int PC_MQ = 0, PC_MK = 256, PC_MV = 512, PC_MO = 768, PC_AQ = 1024, PC_AK = 1280, PC_AV = 1536, PC_IQ = 1792, PC_SZ = 2048, PC_XBC = 2560, PC_IK = 3584;
constexpr int NPH = 1 + 9 * NLAYER;

constexpr size_t MiB = 1u << 20;
constexpr size_t WS_CTL = 0;
constexpr size_t WS_CS = 1 * MiB;
constexpr size_t WS_GATES = 2 * MiB;
constexpr size_t WS_SMALL = 4 * MiB;
constexpr size_t WS_WIN = 5 * MiB;
constexpr size_t WS_WOUT = WS_WIN + 3840ull * 1024 * 2;
constexpr size_t WS_WGU = WS_WOUT + 1024ull * 1024 * 2;
constexpr size_t WS_WDN = WS_WGU + 5632ull * 1024 * 2;
constexpr size_t WS_H = 32 * MiB;
constexpr size_t WS_MST = WS_H;
constexpr size_t WS_SEL = WS_H + 17 * MiB;
constexpr size_t WS_R2 = 64 * MiB;
constexpr size_t WS_MIX = WS_R2, WS_SST = WS_R2 + 32 * MiB;
constexpr size_t WS_R1 = 128 * MiB;
constexpr size_t WS_END = 248 * MiB;
static_assert(WS_WDN + 1024ull * 2816 * 2 <= WS_H, "weights");
constexpr int SM_BLAST = 0, SM_MLOC = 1024, SM_M = 2048, SM_ALAST = 3072  , SM_SELCNT = 8192  ;

constexpr int LDS_BYTES = 147456;

struct Ctx {
    LAS unsigned char* lds; int tid, lane, wave, G, bid;
    const float* x_in; const int* pos; const float *norm_w, *w_in, *gate_b, *mnorm_w, *conv_w, *conv_b, *dt_bias, *a_log, *d_skip, *snorm_w, *w_out, *w_gate, *w_up, *w_down;
    float* out; unsigned char* ws;
};

__device__ __forceinline__ unsigned f2bf(float f) { unsigned u = __float_as_uint(f); return (u + 0x7fffu + ((u >> 16) & 1u)) >> 16; }
__device__ __forceinline__ float bf2f(unsigned h) { return __uint_as_float(h << 16); }
__device__ __forceinline__ unsigned pk2(float lo, float hi) { return f2bf(lo) | (f2bf(hi) << 16); }
__device__ __forceinline__ float bflo(unsigned w) { return __uint_as_float(w << 16); }
__device__ __forceinline__ float bfhi(unsigned w) { return __uint_as_float(w & 0xffff0000u); }
#define LDS_WAIT() asm volatile("s_waitcnt lgkmcnt(0)" ::: "memory")
__device__ __forceinline__ int opaque_v(int v) { asm volatile("" : "+v"(v)); return v; }
__device__ __forceinline__ float wave_sum(float v) {
#pragma unroll
    for (int o = 1; o < 64; o <<= 1) v += __shfl_xor(v, o);
    return v;
}
__device__ __forceinline__ float wave_max(float v) {
#pragma unroll
    for (int o = 1; o < 64; o <<= 1) v = fmaxf(v, __shfl_xor(v, o));
    return v;
}
__device__ __forceinline__ int wave_sum_i(int v) {
#pragma unroll
    for (int o = 1; o < 64; o <<= 1) v += __shfl_xor(v, o);
    return v;
}
__device__ __forceinline__ float wave_scan_incl(float v, int lane) {
#pragma unroll
    for (int o = 1; o < 64; o <<= 1) { const float t = __shfl_up(v, o); if (lane >= o) v += t; }
    return v;
}
__device__ __forceinline__ float row16_sum(float v) { v += __shfl_xor(v, 1); v += __shfl_xor(v, 2); v += __shfl_xor(v, 4); v += __shfl_xor(v, 8); return v; }
__device__ __forceinline__ float row16_max(float v) { v = fmaxf(v, __shfl_xor(v, 1)); v = fmaxf(v, __shfl_xor(v, 2)); v = fmaxf(v, __shfl_xor(v, 4)); v = fmaxf(v, __shfl_xor(v, 8)); return v; }
__device__ __forceinline__ float softplus_f(float y) { return y > 20.0f ? y : log1pf(expf(y)); }
__device__ __forceinline__ float sigmoid_f(float z) { return __builtin_amdgcn_rcpf(1.0f + __expf(-z)); }

#define MFMA16(a, b, c) __builtin_amdgcn_mfma_f32_16x16x32_bf16(a, b, c, 0, 0, 0)
__device__ __forceinline__ bf16x8 ldN(const LAS bf16_t* base, int ld, int lane) { return *(const LAS bf16x8*)(base + (lane & 15) * ld + 8 * (lane >> 4)); }
__device__ __forceinline__ bf16x8 ldT(const LAS bf16_t* base, int ld, int lane) {
    const LAS bf16_t* p = base + (8 * (lane >> 4)) * ld + (lane & 15); bf16x8 v;
#pragma unroll
    for (int j = 0; j < 8; ++j) v[j] = (short)p[j * ld];
    return v;
}
__device__ __forceinline__ bf16x8 ones_frag(int lane) { const short o = (lane & 15) == 0 ? (short)0x3F80 : (short)0; return (bf16x8){o, o, o, o, o, o, o, o}; }
__device__ __forceinline__ f32x4 zero4() { return (f32x4){0.f, 0.f, 0.f, 0.f}; }

__device__ __forceinline__ void transpose_item(const float* colp, int ldw, bf16_t* WT, int K, int n0, int k0, LAS float* scr, int lane) {
#pragma unroll 8
    for (int i = 0; i < 32; ++i) { const int kk = 2 * i + (lane >> 5); scr[kk * 33 + (lane & 31)] = colp ? colp[(size_t)(k0 + kk) * ldw] : 0.0f; }
    LDS_WAIT();
    const int c = lane & 7;
#pragma unroll
    for (int j = 0; j < 4; ++j) { const int n = (lane >> 3) + 8 * j; const LAS float* s = scr + (8 * c) * 33 + n;
        u32x4 o; o.x = pk2(s[0 * 33], s[1 * 33]); o.y = pk2(s[2 * 33], s[3 * 33]); o.z = pk2(s[4 * 33], s[5 * 33]); o.w = pk2(s[6 * 33], s[7 * 33]);
        *(u32x4*)(WT + (size_t)(n0 + n) * K + k0 + 8 * c) = o; }
    LDS_WAIT();
}
__device__ __forceinline__ int proj_src(int n) {
    if (n < 1024) return n;
    if (n < 1792) return n + 8;
    if (n < 2048) return 1800 + (n - 1792);
    if (n < 2560) return 2124 + (n - 2048);
    if (n < 3584) return 2636 + (n - 2560);
    if (n < 3648) return 2056 + (n - 3584);
    if (n < 3656) return 1024 + (n - 3648);
    if (n < 3660) return 2120 + (n - 3656);
    if (n < 3668) return n;
    return -1;
}
__device__ __forceinline__ void convert_layer(const Ctx& X, int l) {
    LAS float* scr = (LAS float*)(X.lds + X.wave * 16384);
    const int gw = X.bid * NWAVES + X.wave, NGW = X.G * NWAVES, lane = X.lane;
    bf16_t* WinT = (bf16_t*)(X.ws + WS_WIN); bf16_t* WoutT = (bf16_t*)(X.ws + WS_WOUT); bf16_t* WguT = (bf16_t*)(X.ws + WS_WGU); bf16_t* WdnT = (bf16_t*)(X.ws + WS_WDN);
    constexpr int I_IN = 16 * 120, I_OUT = 16 * 32, I_GU = 16 * 176, I_DN = 44 * 32, NIT = I_IN + I_OUT + I_GU + I_DN;
    for (int it = gw; it < NIT; it += NGW) {
        int r = it;
        if (r < I_IN) { const int kb = r / 120, nb = r % 120; const int src = proj_src(nb * 32 + (lane & 31));
            const float* colp = src >= 0 ? X.w_in + (size_t)l * 1024 * NIN + src : nullptr;
            transpose_item(colp, NIN, WinT, 1024, nb * 32, kb * 64, scr, lane); continue; }
        r -= I_IN;
        if (r < I_OUT) { const int kb = r / 32, nb = r % 32;
            transpose_item(X.w_out + (size_t)l * 1024 * 1024 + nb * 32 + (lane & 31), 1024, WoutT, 1024, nb * 32, kb * 64, scr, lane); continue; }
        r -= I_OUT;
        if (r < I_GU) { const int kb = r / 176, nb = r % 176; const int n = nb * 32 + (lane & 31), pn = n >> 8, rr = n & 255;
            const float* colp = (rr < 128 ? X.w_gate : X.w_up) + (size_t)l * 1024 * DFF + pn * 128 + (rr & 127);
            transpose_item(colp, DFF, WguT, 1024, nb * 32, kb * 64, scr, lane); continue; }
        r -= I_GU;
        { const int kb = r / 32, nb = r % 32;
            transpose_item(X.w_down + (size_t)l * DFF * 1024 + nb * 32 + (lane & 31), 1024, WdnT, DFF, nb * 32, kb * 64, scr, lane); }
    }
}
__device__ __forceinline__ void p0_prologue(const Ctx& X) {
    convert_layer(X, 0);
    float* cs = (float*)(X.ws + WS_CS);
    const float invf[8] = {1.0f, 0.1939227432012558f, 0.03760603070259094f, 0.007292664609849453f, 0.0014142135623842478f, 0.00027424818836152554f, 5.318296098266728e-05f, 1.0313386155758053e-05f};
    for (int g = X.bid * NTHR + X.tid; g < SEQ * 8; g += X.G * NTHR) {
        const int t = g >> 3, i = g & 7;
        float f = invf[0];
#pragma unroll
        for (int k = 1; k < 8; ++k) f = (i == k) ? invf[k] : f;
        const float ang = (float)X.pos[t] * f;
        double rev = (double)ang * 0.15915494309189535; rev -= rint(rev);
        const float fr = (float)rev;
        cs[t * 16 + i] = __builtin_amdgcn_cosf(fr); cs[t * 16 + 8 + i] = __builtin_amdgcn_sinf(fr);
    }
    const int gw = X.bid * NWAVES + X.wave, NGW = X.G * NWAVES, lane = X.lane;
    bf16_t* H = (bf16_t*)(X.ws + WS_H);
    for (int m = gw; m < SEQ; m += NGW) {
        const f32x4* xr = (const f32x4*)(X.x_in + (size_t)m * DM) + lane; f32x4 v[4]; float ss = 0.f;
#pragma unroll
        for (int j = 0; j < 4; ++j) { v[j] = xr[64 * j]; ss += (v[j].x * v[j].x + v[j].y * v[j].y) + (v[j].z * v[j].z + v[j].w * v[j].w); }
        const float r = rsqrtf(wave_sum(ss) * (1.0f / DM) + EPSN);
#pragma unroll
        for (int j = 0; j < 4; ++j) { const f32x4 w = ((const f32x4*)X.norm_w)[lane + 64 * j]; const f32x4 o = v[j] * r * w;
            u32x2 pk; pk.x = pk2(o.x, o.y); pk.y = pk2(o.z, o.w); *(u32x2*)(H + (size_t)m * DM + 4 * (lane + 64 * j)) = pk; }
    }
}

__device__ __forceinline__ void norm_phase(const Ctx& X, const float* src, const float* xsrc, const float* nwa, const float* nwb) {
    const int gw = X.bid * NWAVES + X.wave, NGW = X.G * NWAVES, lane = X.lane;
    bf16_t* H = (bf16_t*)(X.ws + WS_H);
    for (int m = gw; m < SEQ; m += NGW) {
        const f32x4* sr = (const f32x4*)(src + (size_t)m * DM) + lane; const f32x4* xr = (const f32x4*)(xsrc + (size_t)m * DM) + lane;
        f32x4 v[4], xv[4]; float ss = 0.f;
#pragma unroll
        for (int j = 0; j < 4; ++j) { v[j] = sr[64 * j]; xv[j] = xr[64 * j]; ss += (v[j].x * v[j].x + v[j].y * v[j].y) + (v[j].z * v[j].z + v[j].w * v[j].w); }
        const float r1 = rsqrtf(wave_sum(ss) * (1.0f / DM) + EPSN);
        float ss2 = 0.f;
#pragma unroll
        for (int j = 0; j < 4; ++j) { const f32x4 w = ((const f32x4*)nwa)[lane + 64 * j]; xv[j] = xv[j] + v[j] * r1 * w;
            ss2 += (xv[j].x * xv[j].x + xv[j].y * xv[j].y) + (xv[j].z * xv[j].z + xv[j].w * xv[j].w);
            ((f32x4*)(X.out + (size_t)m * DM))[lane + 64 * j] = xv[j]; }
        if (nwb) {
            const float r2 = rsqrtf(wave_sum(ss2) * (1.0f / DM) + EPSN);
#pragma unroll
            for (int j = 0; j < 4; ++j) { const f32x4 w = ((const f32x4*)nwb)[lane + 64 * j]; const f32x4 o = xv[j] * r2 * w;
                u32x2 pk; pk.x = pk2(o.x, o.y); pk.y = pk2(o.z, o.w); *(u32x2*)(H + (size_t)m * DM + 4 * (lane + 64 * j)) = pk; }
        }
    }
}

__device__ __forceinline__ void conv_rows4(const bf16_t* proj, const float* cw, const float* cb, int trow0, int ch0, float (&o)[4][8]) {
    float w[4][8], b[8];
#pragma unroll
    for (int j = 0; j < 4; ++j) { const f32x4 a = *(const f32x4*)(cw + j * 1024 + ch0), c = *(const f32x4*)(cw + j * 1024 + ch0 + 4);
        w[j][0] = a.x; w[j][1] = a.y; w[j][2] = a.z; w[j][3] = a.w; w[j][4] = c.x; w[j][5] = c.y; w[j][6] = c.z; w[j][7] = c.w; }
    { const f32x4 a = *(const f32x4*)(cb + ch0), c = *(const f32x4*)(cb + ch0 + 4); b[0] = a.x; b[1] = a.y; b[2] = a.z; b[3] = a.w; b[4] = c.x; b[5] = c.y; b[6] = c.z; b[7] = c.w; }
    u32x4 raw[7];
#pragma unroll
    for (int r = 0; r < 7; ++r) { const int t = trow0 - 3 + r;
        raw[r] = (t >= 0) ? *(const u32x4*)(proj + (size_t)t * LDP + PC_XBC + ch0) : (u32x4){0u, 0u, 0u, 0u}; }
#pragma unroll
    for (int r = 0; r < 4; ++r) {
        float acc[8];
#pragma unroll
        for (int e = 0; e < 8; ++e) acc[e] = b[e];
#pragma unroll
        for (int j = 0; j < 4; ++j) { const u32x4 q = raw[r + j];
            acc[0] += w[j][0] * bflo(q.x); acc[1] += w[j][1] * bfhi(q.x); acc[2] += w[j][2] * bflo(q.y); acc[3] += w[j][3] * bfhi(q.y);
            acc[4] += w[j][4] * bflo(q.z); acc[5] += w[j][5] * bfhi(q.z); acc[6] += w[j][6] * bflo(q.w); acc[7] += w[j][7] * bfhi(q.w); }
#pragma unroll
        for (int e = 0; e < 8; ++e) o[r][e] = acc[e] * sigmoid_f(acc[e]);
    }
}
__device__ __forceinline__ u32x4 pack8(const float (&v)[8], float sc) {
    u32x4 w; w.x = pk2(v[0] * sc, v[1] * sc); w.y = pk2(v[2] * sc, v[3] * sc); w.z = pk2(v[4] * sc, v[5] * sc); w.w = pk2(v[6] * sc, v[7] * sc); return w;
}
__device__ __forceinline__ u32x4 scale8(u32x4 q, float sc) {
    u32x4 w; w.x = pk2(bflo(q.x) * sc, bfhi(q.x) * sc); w.y = pk2(bflo(q.y) * sc, bfhi(q.y) * sc); w.z = pk2(bflo(q.z) * sc, bfhi(q.z) * sc); w.w = pk2(bflo(q.w) * sc, bfhi(q.w) * sc); return w;
}

__device__ __forceinline__ void b1_chunk(const Ctx& X, int l, int c) {
    const int tid = opaque_v(X.tid), lane = tid & 63, wave = X.wave, t0 = c * 64;
    const bf16_t* proj = (const bf16_t*)(X.ws + WS_R1); const float* gates = (const float*)(X.ws + WS_GATES);
    float* small = (float*)(X.ws + WS_SMALL);
    {
        LAS bf16_t* Xs = (LAS bf16_t*)(X.lds);
        LAS bf16_t* Bm = (LAS bf16_t*)(X.lds + 66560);
        LAS float* sW = (LAS float*)(X.lds + 66560 + 33792);
        {
            const int h = wave; const float dtb = X.dt_bias[l * 8 + h], A = -expf(X.a_log[l * 8 + h]);
            const float dt = softplus_f(gates[(size_t)(t0 + lane) * 32 + 12 + h] + dtb);
            const float ac = wave_scan_incl(dt * A, lane); const float alast = __shfl(ac, 63);
            sW[h * 64 + lane] = expf(alast - ac) * dt;
            if (lane == 63) small[SM_ALAST + c * 8 + h] = alast;
        }
        __syncthreads();
        const float* cw = X.conv_w + (size_t)l * 4 * 1024; const float* cb = X.conv_b + (size_t)l * 1024;
        for (int idx = tid; idx < 96 * 16; idx += NTHR) {
            const int cgp = idx % 96, rb = idx / 96, ch0 = cgp * 8;
            float o[4][8]; conv_rows4(proj, cw, cb, t0 + 4 * rb, ch0, o);
#pragma unroll
            for (int r = 0; r < 4; ++r) { const int row = 4 * rb + r;
                if (ch0 < 512) { const float sc = sW[(ch0 >> 6) * 64 + row]; *(LAS u32x4*)(Xs + row * 520 + ch0) = pack8(o[r], sc); }
                else *(LAS u32x4*)(Bm + row * 264 + (ch0 - 512)) = pack8(o[r], 1.0f); }
        }
        __syncthreads();
        {
            const int h = wave, g = h >> 2;
            bf16_t* dst = (bf16_t*)(X.ws + WS_SST) + (size_t)(c * 8 + h) * 64 * 128;
#pragma unroll 1
            for (int nh = 0; nh < 2; ++nh) {
                f32x4 acc[4][4];
#pragma unroll
                for (int mi = 0; mi < 4; ++mi)
#pragma unroll
                    for (int ni = 0; ni < 4; ++ni) acc[mi][ni] = zero4();
#pragma unroll
                for (int ks = 0; ks < 2; ++ks) {
                    bf16x8 af[4], bfr[4];
#pragma unroll
                    for (int mi = 0; mi < 4; ++mi) af[mi] = ldT(Xs + (32 * ks) * 520 + h * 64 + 16 * mi, 520, lane);
#pragma unroll
                    for (int ni = 0; ni < 4; ++ni) bfr[ni] = ldT(Bm + (32 * ks) * 264 + g * 128 + nh * 64 + 16 * ni, 264, lane);
#pragma unroll
                    for (int mi = 0; mi < 4; ++mi)
#pragma unroll
                        for (int ni = 0; ni < 4; ++ni) acc[mi][ni] = MFMA16(af[mi], bfr[ni], acc[mi][ni]);
                }
#pragma unroll
                for (int mi = 0; mi < 4; ++mi)
#pragma unroll
                    for (int ni = 0; ni < 4; ++ni)
#pragma unroll
                        for (int j = 0; j < 4; ++j) dst[(16 * mi + 4 * (lane >> 4) + j) * 128 + nh * 64 + 16 * ni + (lane & 15)] = (bf16_t)f2bf(acc[mi][ni][j]);
            }
        }
        __syncthreads();
    }
    {
        LAS bf16_t* Kw = (LAS bf16_t*)(X.lds);
        LAS bf16_t* Vm = (LAS bf16_t*)(X.lds + 33792);
        LAS float* sWm = (LAS float*)(X.lds + 67584);
        if (wave < 4) {
            const int h = wave;
            const float ipre = gates[(size_t)(t0 + lane) * 32 + h] + X.gate_b[l * 8 + h];
            const float fpre = gates[(size_t)(t0 + lane) * 32 + 4 + h] + X.gate_b[l * 8 + 4 + h];
            const float lf = -softplus_f(-fpre);
            const float b = wave_scan_incl(lf, lane); const float blast = __shfl(b, 63);
            const float logw = blast - b + ipre; const float mloc = wave_max(logw);
            sWm[h * 64 + lane] = expf(logw - mloc);
            if (lane == 0) { small[SM_BLAST + c * 4 + h] = blast; small[SM_MLOC + c * 4 + h] = mloc; }
        }
        __syncthreads();
#pragma unroll
        for (int i = 0; i < 8; ++i) {
            const int idx = tid + NTHR * i, mat = idx >> 11, rem = idx & 2047, row = rem >> 5, ch = (rem & 31) * 8;
            u32x4 v = *(const u32x4*)(proj + (size_t)(t0 + row) * LDP + (mat ? PC_MV : PC_MK) + ch);
            if (!mat) v = scale8(v, sWm[(ch >> 6) * 64 + row]);
            *(LAS u32x4*)((mat ? Vm : Kw) + row * 264 + ch) = v;
        }
        __syncthreads();
        {
            const int hh = wave >> 1, dh = wave & 1;
            f32x4 acc[5][2];
#pragma unroll
            for (int ei = 0; ei < 5; ++ei) { acc[ei][0] = zero4(); acc[ei][1] = zero4(); }
#pragma unroll
            for (int ks = 0; ks < 2; ++ks) {
                bf16x8 af[5], bfr[2];
#pragma unroll
                for (int ei = 0; ei < 4; ++ei) af[ei] = ldT(Vm + (32 * ks) * 264 + hh * 64 + 16 * ei, 264, lane);
                af[4] = ones_frag(lane);
#pragma unroll
                for (int ni = 0; ni < 2; ++ni) bfr[ni] = ldT(Kw + (32 * ks) * 264 + hh * 64 + dh * 32 + 16 * ni, 264, lane);
#pragma unroll
                for (int ei = 0; ei < 5; ++ei)
#pragma unroll
                    for (int ni = 0; ni < 2; ++ni) acc[ei][ni] = MFMA16(af[ei], bfr[ni], acc[ei][ni]);
            }
            float* dst = (float*)(X.ws + WS_MST) + (size_t)(c * 4 + hh) * 65 * 64;
#pragma unroll
            for (int ei = 0; ei < 5; ++ei)
#pragma unroll
                for (int ni = 0; ni < 2; ++ni)
#pragma unroll
                    for (int j = 0; j < 4; ++j) { const int e = 16 * ei + 4 * (lane >> 4) + j; if (e <= 64) dst[e * 64 + dh * 32 + 16 * ni + (lane & 15)] = acc[ei][ni][j]; }
        }
        __syncthreads();
    }
}

__device__ __forceinline__ unsigned mono_u(unsigned u) { return (u & 0x80000000u) ? ~u : (u | 0x80000000u); }
__device__ __forceinline__ unsigned unmono_u(unsigned k) { return (k & 0x80000000u) ? (k & 0x7fffffffu) : ~k; }
__device__ __forceinline__ void topk_prune(LAS u32x2* cq, int n, LAS int* cntq, LAS float* thrq, int lane) {
    unsigned long long key[16];
#pragma unroll
    for (int i = 0; i < 16; ++i) { const int idx = lane + 64 * i; unsigned long long k = 0ull;
        if (idx < n) { const u32x2 e = cq[idx]; k = ((unsigned long long)mono_u(e.x) << 14) | (unsigned long long)(16383u - e.y); }
        key[i] = k; }
    unsigned long long T = 0ull;
#pragma unroll 1
    for (int bit = 45; bit >= 0; --bit) {
        const unsigned long long cnd = T | (1ull << bit); int cc = 0;
#pragma unroll
        for (int i = 0; i < 16; ++i) cc += (key[i] >= cnd) ? 1 : 0;
        cc = wave_sum_i(cc);
        if (cc >= 256) T = cnd;
    }
    int base = 0;
#pragma unroll
    for (int i = 0; i < 16; ++i) {
        const bool kp = key[i] >= T;
        const unsigned long long mk = __ballot(kp);
        const int pos = base + __popcll(mk & ((1ull << lane) - 1ull));
        if (kp) cq[pos] = (u32x2){unmono_u((unsigned)(key[i] >> 14)), 16383u - (unsigned)(key[i] & 16383ull)};
        base += __popcll(mk);
    }
    if (lane == 0) { *cntq = 256; *thrq = __uint_as_float(unmono_u((unsigned)(T >> 14))); }
}
__device__ __forceinline__ void dsa_index_item(const Ctx& X, int item) {
    const int tid = X.tid, lane = X.lane, wave = X.wave, t0 = item * 16;
    const bf16_t* proj = (const bf16_t*)(X.ws + WS_R1); const float* gates = (const float*)(X.ws + WS_GATES);
    LAS u32x2* cand = (LAS u32x2*)X.lds;
    LAS int* cnt = (LAS int*)(X.lds + 131072); LAS float* thr = (LAS float*)(X.lds + 131072 + 64);
    unsigned short* sel = (unsigned short*)(X.ws + WS_SEL); int* selcnt = (int*)(X.ws + WS_SMALL) + SM_SELCNT;
    if (tid < 16) { cnt[tid] = 0; thr[tid] = -INFINITY; }
    bf16x8 af[4][2]; float wq[4][4];
#pragma unroll
    for (int mt = 0; mt < 4; ++mt) {
        const bf16_t* b = proj + (size_t)(t0 + 4 * mt + ((lane & 15) >> 2)) * LDP + PC_IQ + 64 * (lane & 3) + 8 * (lane >> 4);
        af[mt][0] = *(const bf16x8*)b; af[mt][1] = *(const bf16x8*)(b + 32);
        const f32x4 w4 = *(const f32x4*)(gates + (size_t)(t0 + 4 * mt + (lane >> 4)) * 32 + 8);
        wq[mt][0] = w4.x; wq[mt][1] = w4.y; wq[mt][2] = w4.z; wq[mt][3] = w4.w;
    }
    float th[4] = {-INFINITY, -INFINITY, -INFINITY, -INFINITY};
    __syncthreads();
    const int nsteps = (t0 + 15) / 128 + 1;
#pragma unroll 1
    for (int st = 0; st < nsteps; ++st) {
        const int key = st * 128 + wave * 16 + (lane & 15);
        const bf16_t* kb = proj + (size_t)key * LDP + PC_IK + 8 * (lane >> 4);
        const bf16x8 b0 = *(const bf16x8*)kb, b1 = *(const bf16x8*)(kb + 32);
#pragma unroll
        for (int mt = 0; mt < 4; ++mt) {
            f32x4 acc = zero4(); acc = MFMA16(af[mt][0], b0, acc); acc = MFMA16(af[mt][1], b1, acc);
            float sc = wq[mt][0] * fmaxf(acc[0], 0.f) + wq[mt][1] * fmaxf(acc[1], 0.f) + wq[mt][2] * fmaxf(acc[2], 0.f) + wq[mt][3] * fmaxf(acc[3], 0.f);
            sc = (sc == 0.0f) ? 0.0f : sc;
            const int q = 4 * mt + (lane >> 4);
            if (key <= t0 + q && sc > th[mt]) { const int pos = __hip_atomic_fetch_add(&cnt[q], 1, __ATOMIC_RELAXED, __HIP_MEMORY_SCOPE_WORKGROUP); cand[q * 1024 + pos] = (u32x2){__float_as_uint(sc), (unsigned)key}; }
        }
        const bool last = (st == nsteps - 1);
        if ((st & 3) == 3 || last) {
            __syncthreads();
#pragma unroll 1
            for (int qq = 0; qq < 2; ++qq) {
                const int q = wave * 2 + qq; int n = cnt[q];
                if (n > 512 || (last && n > 256)) { topk_prune(cand + q * 1024, n, cnt + q, thr + q, lane); n = 256; }
                if (last) {
                    LDS_WAIT();
                    unsigned my[4]; int rk[4];
#pragma unroll
                    for (int k = 0; k < 4; ++k) { const int i = lane + 64 * k; my[k] = (i < n) ? cand[q * 1024 + i].y : 0xffffffffu; rk[k] = 0; }
#pragma unroll 4
                    for (int j = 0; j < n; ++j) { const unsigned v = cand[q * 1024 + j].y;
#pragma unroll
                        for (int k = 0; k < 4; ++k) rk[k] += (v < my[k]) ? 1 : 0; }
#pragma unroll
                    for (int k = 0; k < 4; ++k) if (lane + 64 * k < n) sel[(size_t)(t0 + q) * 256 + rk[k]] = (unsigned short)my[k];
                    if (lane == 0) selcnt[t0 + q] = n;
                }
            }
            __syncthreads();
#pragma unroll
            for (int mt = 0; mt < 4; ++mt) th[mt] = thr[4 * mt + (lane >> 4)];
        }
    }
    __syncthreads();
}

__device__ __forceinline__ void b2_scan(const Ctx& X) {
    float* small = (float*)(X.ws + WS_SMALL);
    const int NT = X.G * NTHR;
    for (int g = X.bid * NTHR + X.tid; g < 65536 + 16640; g += NT) {
        if (g < 65536) {
            const int h = g >> 13; bf16_t* p = (bf16_t*)(X.ws + WS_SST) + g; float st = 0.f;
#pragma unroll 8
            for (int c = 0; c < 256; ++c) { const float dec = __expf(small[SM_ALAST + c * 8 + h]); const float loc = bf2f(p[(size_t)c * 65536]);
                p[(size_t)c * 65536] = (bf16_t)f2bf(st); st = st * dec + loc; }
        } else {
            const int q = g - 65536, h = q / 4160; float* p = (float*)(X.ws + WS_MST) + q; float st = 0.f, m = 0.f; const bool wr = (q % 4160) == 0;
#pragma unroll 8
            for (int c = 0; c < 256; ++c) {
                const float bl = small[SM_BLAST + c * 4 + h], ml = small[SM_MLOC + c * 4 + h];
                const float mn = fmaxf(bl + m, ml); const float dec = __expf(bl + m - mn), isc = __expf(ml - mn);
                if (wr) small[SM_M + c * 4 + h] = m;
                const float loc = p[(size_t)c * 16640]; p[(size_t)c * 16640] = st; st = st * dec + isc * loc; m = mn; }
        }
    }
}

__device__ __forceinline__ void b3_chunk(const Ctx& X, int l, int c) {
    const int wave = X.wave, t0 = c * 64;
    const bf16_t* proj = (const bf16_t*)(X.ws + WS_R1); const float* gates = (const float*)(X.ws + WS_GATES);
    const float* small = (const float*)(X.ws + WS_SMALL);
    bf16_t* mix = (bf16_t*)(X.ws + WS_MIX);
    const int hl = wave >> 2, wq = wave & 3;
#pragma unroll 1
    for (int hp = 0; hp < 2; ++hp) {
        const int tid = opaque_v(X.tid), lane = tid & 63, lr = lane & 15, lq = lane >> 4;
        LAS unsigned char* slot = X.lds + hl * 49152;
        {
#pragma unroll
            for (int i = 0; i < 6; ++i) {
                const int idx = tid + NTHR * i, shl = idx / 1536, rem = idx % 1536, mat = rem >> 9, r2 = rem & 511, row = r2 >> 3, ch = (r2 & 7) * 8, h = 2 * hp + shl;
                u32x4 v = *(const u32x4*)(proj + (size_t)(t0 + row) * LDP + (mat == 0 ? PC_MQ : (mat == 1 ? PC_MK : PC_MV)) + h * 64 + ch);
                if (mat == 0) v = scale8(v, 0.125f);
                *(LAS u32x4*)(X.lds + shl * 49152 + mat * 9216 + (row * 72 + ch) * 2) = v;
            }
#pragma unroll
            for (int i = 0; i < 3; ++i) {
                const int idx = tid + NTHR * i;
                if (idx < 1280) { const int shl = idx / 640, rem = idx % 640, e = rem >> 3, d0 = (rem & 7) * 8, h = 2 * hp + shl;
                    u32x4 v = (u32x4){0u, 0u, 0u, 0u};
                    if (e <= 64) { const float* s = (const float*)(X.ws + WS_MST) + (size_t)(c * 4 + h) * 4160 + e * 64 + d0; const f32x4 a = *(const f32x4*)s, b = *(const f32x4*)(s + 4);
                        v.x = pk2(a.x, a.y); v.y = pk2(a.z, a.w); v.z = pk2(b.x, b.y); v.w = pk2(b.z, b.w); }
                    *(LAS u32x4*)(X.lds + shl * 49152 + 36864 + (e * 72 + d0) * 2) = v; }
            }
            if ((wave & 3) == 0) {
                const int h = 2 * hp + hl;
                const float ipre = gates[(size_t)(t0 + lane) * 32 + h] + X.gate_b[l * 8 + h];
                const float fpre = gates[(size_t)(t0 + lane) * 32 + 4 + h] + X.gate_b[l * 8 + 4 + h];
                const float b = wave_scan_incl(-softplus_f(-fpre), lane);
                ((LAS float*)(slot + 48384))[lane] = b; ((LAS float*)(slot + 48640))[lane] = ipre;
            }
        }
        __syncthreads();
        const int h = 2 * hp + hl;
        const LAS bf16_t* Q = (const LAS bf16_t*)slot; const LAS bf16_t* K = (const LAS bf16_t*)(slot + 9216); const LAS bf16_t* V = (const LAS bf16_t*)(slot + 18432);
        LAS bf16_t* Sm = (LAS bf16_t*)(slot + 27648); const LAS bf16_t* Ct = (const LAS bf16_t*)(slot + 36864);
        const LAS float* sB = (const LAS float*)(slot + 48384); const LAS float* sI = (const LAS float*)(slot + 48640);
        const float mc = small[SM_M + c * 4 + h];
        bf16x8 qf[2]; qf[0] = ldN(Q + 16 * wq * 72, 72, lane); qf[1] = ldN(Q + 16 * wq * 72 + 32, 72, lane);
        f32x4 sacc[4];
#pragma unroll
        for (int ni = 0; ni < 4; ++ni) { sacc[ni] = zero4();
#pragma unroll
            for (int ks = 0; ks < 2; ++ks) sacc[ni] = MFMA16(qf[ks], ldN(K + 16 * ni * 72 + 32 * ks, 72, lane), sacc[ni]); }
        float scl[4], emt[4];
#pragma unroll
        for (int j = 0; j < 4; ++j) {
            const int t = 16 * wq + 4 * lq + j; const float bt = sB[t]; float ldv[4]; float mx = -INFINITY;
#pragma unroll
            for (int ni = 0; ni < 4; ++ni) { const int s = 16 * ni + lr; ldv[ni] = (s <= t) ? (bt - sB[s] + sI[s]) : -INFINITY; mx = fmaxf(mx, ldv[ni]); }
            mx = row16_max(mx);
            const float mt = fmaxf(bt + mc, mx);
#pragma unroll
            for (int ni = 0; ni < 4; ++ni) { const int s = 16 * ni + lr; const float val = (s <= t) ? sacc[ni][j] * __expf(ldv[ni] - mt) : 0.0f; Sm[t * 72 + s] = (bf16_t)f2bf(val); }
            scl[j] = __expf(bt + mc - mt); emt[j] = __expf(-mt);
        }
        __syncthreads();
        f32x4 nacc[5], cacc[5];
#pragma unroll
        for (int ei = 0; ei < 5; ++ei) { nacc[ei] = zero4(); cacc[ei] = zero4();
#pragma unroll
            for (int ks = 0; ks < 2; ++ks) {
                const bf16x8 a = ldN(Sm + 16 * wq * 72 + 32 * ks, 72, lane);
                const bf16x8 b = (ei < 4) ? ldT(V + (32 * ks) * 72 + 16 * ei, 72, lane) : ones_frag(lane);
                nacc[ei] = MFMA16(a, b, nacc[ei]);
                cacc[ei] = MFMA16(qf[ks], ldN(Ct + 16 * ei * 72 + 32 * ks, 72, lane), cacc[ei]); } }
#pragma unroll
        for (int j = 0; j < 4; ++j) {
            const int t = 16 * wq + 4 * lq + j;
            float den = nacc[4][j] + scl[j] * cacc[4][j]; den = __shfl(den, lane & 48);
            const float inv = 1.0f / fmaxf(fabsf(den), emt[j]);
            float hv[4]; float ss = 0.f;
#pragma unroll
            for (int ei = 0; ei < 4; ++ei) { hv[ei] = (nacc[ei][j] + scl[j] * cacc[ei][j]) * inv; ss += hv[ei] * hv[ei]; }
            ss = row16_sum(ss);
            const float r = rsqrtf(ss * (1.0f / 64.0f) + EPSN);
#pragma unroll
            for (int ei = 0; ei < 4; ++ei) { const int e = 16 * ei + lr;
                const float w = X.mnorm_w[l * 256 + h * 64 + e]; const float mo = bf2f(proj[(size_t)(t0 + t) * LDP + PC_MO + h * 64 + e]);
                mix[(size_t)(t0 + t) * DM + h * 64 + e] = (bf16_t)f2bf(hv[ei] * r * w * sigmoid_f(mo)); }
        }
        __syncthreads();
    }
    const float* cw = X.conv_w + (size_t)l * 4 * 1024; const float* cb = X.conv_b + (size_t)l * 1024;
#pragma unroll 1
    for (int g = 0; g < 2; ++g) {
        const int tid = opaque_v(X.tid), lane = tid & 63, lr = lane & 15, lq = lane >> 4;
        LAS bf16_t* Cm = (LAS bf16_t*)(X.lds);
        LAS bf16_t* Bm = (LAS bf16_t*)(X.lds + 17408);
        LAS float* Gs = (LAS float*)(X.lds + 34816);
        LAS float* sDt = (LAS float*)(X.lds + 123904);
        LAS float* sAc = (LAS float*)(X.lds + 124928);
        LAS float* ssq = (LAS float*)(X.lds + 125952);
        if (wave < 4) {
            const int h = 4 * g + wave; const float dtb = X.dt_bias[l * 8 + h], A = -expf(X.a_log[l * 8 + h]);
            const float dt = softplus_f(gates[(size_t)(t0 + lane) * 32 + 12 + h] + dtb);
            const float ac = wave_scan_incl(dt * A, lane);
            sDt[wave * 64 + lane] = dt; sAc[wave * 64 + lane] = ac;
        }
        {
            const int rb = tid >> 5, cgp = tid & 31, mat = cgp >> 4, chl = (cgp & 15) * 8;
            float o[4][8]; conv_rows4(proj, cw, cb, t0 + 4 * rb, 512 + mat * 256 + g * 128 + chl, o);
#pragma unroll
            for (int r = 0; r < 4; ++r) *(LAS u32x4*)((mat ? Cm : Bm) + (4 * rb + r) * 136 + chl) = pack8(o[r], 1.0f);
        }
        __syncthreads();
        {
            const int ti = wave >> 1;
#pragma unroll
            for (int sj = 0; sj < 2; ++sj) { const int si = 2 * (wave & 1) + sj; f32x4 acc = zero4();
#pragma unroll
                for (int ks = 0; ks < 4; ++ks) acc = MFMA16(ldN(Cm + 16 * ti * 136 + 32 * ks, 136, lane), ldN(Bm + 16 * si * 136 + 32 * ks, 136, lane), acc);
#pragma unroll
                for (int j = 0; j < 4; ++j) Gs[(16 * ti + 4 * lq + j) * 68 + 16 * si + lr] = acc[j]; }
        }
        float gat[2][4][4];
#pragma unroll
        for (int hp = 0; hp < 2; ++hp) {
            LAS unsigned char* slot = X.lds + 52224 + hl * 35840;
            LAS bf16_t* Pm = (LAS bf16_t*)slot; LAS bf16_t* Xh = (LAS bf16_t*)(slot + 9216); LAS bf16_t* St = (LAS bf16_t*)(slot + 18432);
            if (tid < 256) {
                const int shl = tid >> 7, rem = tid & 127, rb = rem >> 3, chl = (rem & 7) * 8, h = 4 * g + 2 * hp + shl;
                float o[4][8]; conv_rows4(proj, cw, cb, t0 + 4 * rb, h * 64 + chl, o);
#pragma unroll
                for (int r = 0; r < 4; ++r) *(LAS u32x4*)(X.lds + 52224 + shl * 35840 + 9216 + ((4 * rb + r) * 72 + chl) * 2) = pack8(o[r], 1.0f);
            }
#pragma unroll
            for (int i = 0; i < 4; ++i) {
                const int idx = tid + NTHR * i, shl = idx >> 10, rem = idx & 1023, p = rem >> 4, n0 = (rem & 15) * 8, h = 4 * g + 2 * hp + shl;
                const u32x4 v = *(const u32x4*)((const bf16_t*)(X.ws + WS_SST) + ((size_t)(c * 8 + h) * 64 + p) * 128 + n0);
                *(LAS u32x4*)(X.lds + 52224 + shl * 35840 + 18432 + (p * 136 + n0) * 2) = v;
            }
            __syncthreads();
            const int hh = 2 * hp + hl, h = 4 * g + hh;
#pragma unroll
            for (int j = 0; j < 4; ++j) {
                const int t = 16 * wq + 4 * lq + j; const float at = sAc[hh * 64 + t];
#pragma unroll
                for (int ni = 0; ni < 4; ++ni) { const int s = 16 * ni + lr;
                    const float val = (s <= t) ? Gs[t * 68 + s] * __expf(at - sAc[hh * 64 + s]) * sDt[hh * 64 + s] : 0.0f;
                    Pm[t * 72 + s] = (bf16_t)f2bf(val); }
            }
            __syncthreads();
            f32x4 ia[4], ie[4];
#pragma unroll
            for (int pi = 0; pi < 4; ++pi) { ia[pi] = zero4(); ie[pi] = zero4();
#pragma unroll
                for (int ks = 0; ks < 2; ++ks) ia[pi] = MFMA16(ldN(Pm + 16 * wq * 72 + 32 * ks, 72, lane), ldT(Xh + (32 * ks) * 72 + 16 * pi, 72, lane), ia[pi]);
#pragma unroll
                for (int ks = 0; ks < 4; ++ks) ie[pi] = MFMA16(ldN(Cm + 16 * wq * 136 + 32 * ks, 136, lane), ldN(St + 16 * pi * 136 + 32 * ks, 136, lane), ie[pi]); }
            const float dsk = X.d_skip[l * 8 + h];
#pragma unroll
            for (int j = 0; j < 4; ++j) {
                const int t = 16 * wq + 4 * lq + j; const float ea = __expf(sAc[hh * 64 + t]); float ssum = 0.f;
#pragma unroll
                for (int pi = 0; pi < 4; ++pi) { const int p = 16 * pi + lr;
                    const float xv = bf2f(Xh[t * 72 + p]);
                    const float y = ia[pi][j] + ea * ie[pi][j] + dsk * xv;
                    const float z = bf2f(proj[(size_t)(t0 + t) * LDP + PC_SZ + h * 64 + p]);
                    const float gv = y * z * sigmoid_f(z);
                    gat[hp][pi][j] = gv; ssum += gv * gv; }
                ssum = row16_sum(ssum);
                if (lr == 0) ssq[t * 4 + 2 * hp + hl] = ssum;
            }
            __syncthreads();
        }
#pragma unroll
        for (int hp = 0; hp < 2; ++hp) {
            const int h = 4 * g + 2 * hp + hl;
#pragma unroll
            for (int j = 0; j < 4; ++j) {
                const int t = 16 * wq + 4 * lq + j; const float r = rsqrtf(((ssq[t * 4 + 0] + ssq[t * 4 + 1]) + (ssq[t * 4 + 2] + ssq[t * 4 + 3])) * (1.0f / 256.0f) + EPSN);
#pragma unroll
                for (int pi = 0; pi < 4; ++pi) { const int p = 16 * pi + lr;
                    mix[(size_t)(t0 + t) * DM + 512 + h * 64 + p] = (bf16_t)f2bf(gat[hp][pi][j] * r * X.snorm_w[l * 512 + h * 64 + p]); }
            }
        }
        __syncthreads();
    }
}

__device__ __forceinline__ void dsa_attend(const Ctx& X, int t) {
    const int lane = X.lane, hd = lane >> 4;
    const bf16_t* proj = (const bf16_t*)(X.ws + WS_R1);
    LAS float* lg = (LAS float*)(X.lds + X.wave * 4096);
    const unsigned short* srow = (const unsigned short*)(X.ws + WS_SEL) + (size_t)t * 256;
    const int n = ((const int*)(X.ws + WS_SMALL))[SM_SELCNT + t];
    unsigned sr0 = (lane < n) ? srow[lane] : 0u, sr1 = (lane + 64 < n) ? srow[lane + 64] : 0u, sr2 = (lane + 128 < n) ? srow[lane + 128] : 0u, sr3 = (lane + 192 < n) ? srow[lane + 192] : 0u;
    const u32x2 qraw = *(const u32x2*)(proj + (size_t)t * LDP + PC_AQ + 4 * lane);
    const float q0 = bflo(qraw.x) * 0.125f, q1 = bfhi(qraw.x) * 0.125f, q2 = bflo(qraw.y) * 0.125f, q3 = bfhi(qraw.y) * 0.125f;
    const bf16_t* kbase = proj + PC_AK + 4 * lane; const bf16_t* vbase = proj + PC_AV + 4 * lane;
#pragma unroll 1
    for (int i0 = 0; i0 < n; i0 += 8) {
        u32x2 kr[8];
#pragma unroll
        for (int u = 0; u < 8; ++u) { int i = i0 + u; i = i < n ? i : n - 1; const int seg = i >> 6;
            const unsigned sv = seg == 0 ? sr0 : (seg == 1 ? sr1 : (seg == 2 ? sr2 : sr3));
            const int s = __builtin_amdgcn_readlane((int)sv, i & 63);
            kr[u] = *(const u32x2*)(kbase + (size_t)s * LDP); }
#pragma unroll
        for (int u = 0; u < 8; ++u) {
            float d = q0 * bflo(kr[u].x) + q1 * bfhi(kr[u].x) + q2 * bflo(kr[u].y) + q3 * bfhi(kr[u].y);
            d = row16_sum(d);
            if ((lane & 15) == 0 && i0 + u < n) lg[hd * 256 + i0 + u] = d; }
    }
    LDS_WAIT();
    float myinv = 0.f;
#pragma unroll
    for (int hh = 0; hh < 4; ++hh) {
        float v[4]; float mx = -INFINITY;
#pragma unroll
        for (int k = 0; k < 4; ++k) { const int i = lane + 64 * k; v[k] = (i < n) ? lg[hh * 256 + i] : -INFINITY; mx = fmaxf(mx, v[k]); }
        mx = wave_max(mx); float sm = 0.f;
#pragma unroll
        for (int k = 0; k < 4; ++k) { const int i = lane + 64 * k; const float e = (i < n) ? __expf(v[k] - mx) : 0.f; sm += e; if (i < n) lg[hh * 256 + i] = e; }
        sm = wave_sum(sm);
        if (hd == hh) myinv = 1.0f / sm;
    }
    LDS_WAIT();
    float a0 = 0.f, a1 = 0.f, a2 = 0.f, a3 = 0.f;
#pragma unroll 1
    for (int i0 = 0; i0 < n; i0 += 8) {
        u32x2 vr[8];
#pragma unroll
        for (int u = 0; u < 8; ++u) { int i = i0 + u; i = i < n ? i : n - 1; const int seg = i >> 6;
            const unsigned sv = seg == 0 ? sr0 : (seg == 1 ? sr1 : (seg == 2 ? sr2 : sr3));
            const int s = __builtin_amdgcn_readlane((int)sv, i & 63);
            vr[u] = *(const u32x2*)(vbase + (size_t)s * LDP); }
#pragma unroll
        for (int u = 0; u < 8; ++u) {
            const float p = (i0 + u < n) ? lg[hd * 256 + (i0 + u < n ? i0 + u : 0)] : 0.f;
            a0 += p * bflo(vr[u].x); a1 += p * bfhi(vr[u].x); a2 += p * bflo(vr[u].y); a3 += p * bfhi(vr[u].y); }
    }
    u32x2 o; o.x = pk2(a0 * myinv, a1 * myinv); o.y = pk2(a2 * myinv, a3 * myinv);
    *(u32x2*)((bf16_t*)(X.ws + WS_MIX) + (size_t)t * DM + 256 + 4 * lane) = o;
    LDS_WAIT();
}

#ifndef PH_MASK
#define PH_MASK 0x3FF
#endif
#define PH_ON(k) ((PH_MASK >> (k)) & 1)
__device__ __forceinline__ void run_phase(const Ctx& X, int ph) {
    if (ph == 0) { if (PH_ON(9)) p0_prologue(X); return; }
    const int l = (ph - 1) / 9, k = (ph - 1) % 9;
    const bf16_t* H = (const bf16_t*)(X.ws + WS_H);
    switch (k) {
    case 0: if (PH_ON(0)) {
        pg8::Gemm g{H, (const bf16_t*)(X.ws + WS_WIN), SEQ, LDP, 1024}; pg8::StaticOrder S; S.init(SEQ, LDP, X.G, X.bid);
        pg8::EpiProj E{(bf16_t*)(X.ws + WS_R1), LDP, (float*)(X.ws + WS_GATES), (const float*)(X.ws + WS_CS)};
        pg8::gemm_phase<pg8::EpiProj, pg8::StaticOrder, true, true>(X.lds, g, S, E);
    } break;
    case 1: if (PH_ON(1)) {
#ifndef B1_NOCHUNK
        for (int c = X.bid; c < 256; c += X.G) b1_chunk(X, l, c);
#endif
#ifndef B1_NODSA
        for (int i = X.bid; i < 512; i += X.G) { dsa_index_item(X, i); dsa_index_item(X, 1023 - i); }
#endif
    } break;
    case 2: if (PH_ON(2)) b2_scan(X); break;
    case 3: if (PH_ON(3)) {
#ifndef B3_NOCHUNK
        for (int c = X.bid; c < 256; c += X.G) b3_chunk(X, l, c);
#endif
#ifndef B3_NOATT
        for (int t = X.bid * NWAVES + X.wave; t < SEQ; t += X.G * NWAVES) dsa_attend(X, t);
#endif
    } break;
    case 4: if (PH_ON(4)) {
        pg8::Gemm g{(const bf16_t*)(X.ws + WS_MIX), (const bf16_t*)(X.ws + WS_WOUT), SEQ, 1024, 1024}; pg8::StaticOrder S; S.init(SEQ, 1024, X.G, X.bid);
        pg8::EpiF32 E{(float*)(X.ws + WS_R1), 1024};
        pg8::gemm_phase<pg8::EpiF32, pg8::StaticOrder, true, true>(X.lds, g, S, E);
    } break;
    case 5: if (PH_ON(5)) {
        norm_phase(X, (const float*)(X.ws + WS_R1), l == 0 ? X.x_in : X.out, X.norm_w + (size_t)(l * 4 + 1) * DM, X.norm_w + (size_t)(l * 4 + 2) * DM);
    } break;
    case 6: if (PH_ON(6)) {
        pg8::Gemm g{H, (const bf16_t*)(X.ws + WS_WGU), SEQ, 2 * DFF, 1024}; pg8::StaticOrder S; S.init(SEQ, 2 * DFF, X.G, X.bid);
        pg8::EpiSwiGLU E{(bf16_t*)(X.ws + WS_R1), DFF};
        pg8::gemm_phase<pg8::EpiSwiGLU, pg8::StaticOrder, true, true>(X.lds, g, S, E);
    } break;
    case 7: if (PH_ON(7)) {
        pg8::Gemm g{(const bf16_t*)(X.ws + WS_R1), (const bf16_t*)(X.ws + WS_WDN), SEQ, 1024, DFF}; pg8::StaticOrder S; S.init(SEQ, 1024, X.G, X.bid);
        pg8::EpiF32 E{(float*)(X.ws + WS_R2), 1024};
        pg8::gemm_phase<pg8::EpiF32, pg8::StaticOrder, true, true>(X.lds, g, S, E);
    } break;
    default: if (PH_ON(8)) {
        norm_phase(X, (const float*)(X.ws + WS_R2), X.out, X.norm_w + (size_t)(l * 4 + 3) * DM, l + 1 < NLAYER ? X.norm_w + (size_t)((l + 1) * 4) * DM : nullptr);
        if (l + 1 < NLAYER) convert_layer(X, l + 1);
    } break;
    }
}

struct Args { const void* in[16]; float* out; unsigned char* ws; int ph_lo, ph_hi; };
__global__ void __launch_bounds__(NTHR, 2) hyb_fwd(Args a) {
    extern __shared__ __attribute__((aligned(16))) unsigned char lds_raw[];
    Ctx X;
    X.lds = (LAS unsigned char*)lds_raw; X.G = gridDim.x; X.bid = blockIdx.x;
    const int ph_lo = a.ph_lo, ph_hi = a.ph_hi;
#pragma unroll 1
    for (int ph = ph_lo; ph < ph_hi; ++ph) {
        { int t_ = threadIdx.x; asm volatile("" : "+v"(t_)); X.tid = t_; X.lane = t_ & 63; X.wave = __builtin_amdgcn_readfirstlane(t_ >> 6); }
        {
            const __attribute__((address_space(4))) Args* k = (const __attribute__((address_space(4))) Args*)__builtin_amdgcn_kernarg_segment_ptr();
            asm volatile("" : "+s"(k));
            X.x_in = (const float*)k->in[0]; X.pos = (const int*)k->in[1]; X.norm_w = (const float*)k->in[2]; X.w_in = (const float*)k->in[3]; X.gate_b = (const float*)k->in[4];
            X.mnorm_w = (const float*)k->in[5]; X.conv_w = (const float*)k->in[6]; X.conv_b = (const float*)k->in[7]; X.dt_bias = (const float*)k->in[8]; X.a_log = (const float*)k->in[9];
            X.d_skip = (const float*)k->in[10]; X.snorm_w = (const float*)k->in[11]; X.w_out = (const float*)k->in[12]; X.w_gate = (const float*)k->in[13]; X.w_up = (const float*)k->in[14]; X.w_down = (const float*)k->in[15];
            X.out = k->out; X.ws = k->ws;
        }
        run_phase(X, ph);
#if !MK_MULTI
        if (ph + 1 < ph_hi) { cg::this_grid().sync(); }
#endif
    }
}

extern "C" void kernel_launch(void* const* d_in, const int* in_sizes, int n_in, void* d_out, int out_size, void* d_ws, size_t ws_size, hipStream_t stream) {
    static int grid = 0;
    if (grid == 0) {
        if (n_in != 16 || out_size != SEQ * DM || ws_size < WS_END) { fprintf(stderr, "kernel_launch: unexpected shapes (n_in %d out %d ws %zu)\n", n_in, out_size, ws_size); grid = -1; return; }
        int dev = 0, cus = 0, per_cu = 0;
        if (hipGetDevice(&dev) != hipSuccess || hipDeviceGetAttribute(&cus, hipDeviceAttributeMultiprocessorCount, dev) != hipSuccess) { grid = -1; return; }
        if (hipFuncSetAttribute((const void*)hyb_fwd, hipFuncAttributeMaxDynamicSharedMemorySize, LDS_BYTES) != hipSuccess) { fprintf(stderr, "kernel_launch: hipFuncSetAttribute failed\n"); grid = -1; return; }
        if (hipOccupancyMaxActiveBlocksPerMultiprocessor(&per_cu, (const void*)hyb_fwd, NTHR, LDS_BYTES) != hipSuccess || per_cu < 1) { fprintf(stderr, "kernel_launch: occupancy query says %d\n", per_cu); per_cu = 1; }
        (void)hipGetLastError();
        grid = cus * 1;
        if (grid > 256) grid = 256;
    }
    if (grid < 0) return;
    Args a{};
    for (int i = 0; i < 16; ++i) a.in[i] = d_in[i];
    a.out = (float*)d_out; a.ws = (unsigned char*)d_ws;
#if MK_MULTI
    for (int ph = 0; ph < NPH; ++ph) { a.ph_lo = ph; a.ph_hi = ph + 1; hipLaunchKernelGGL(hyb_fwd, dim3(grid), dim3(NTHR), LDS_BYTES, stream, a); }
#else
    a.ph_lo = 0; a.ph_hi = NPH;
    void* args[] = {&a};
    hipError_t e = hipLaunchCooperativeKernel((const void*)hyb_fwd, dim3(grid), dim3(NTHR), args, LDS_BYTES, stream);
    if (e != hipSuccess) fprintf(stderr, "kernel_launch: cooperative launch failed: %s (grid %d)\n", hipGetErrorString(e), grid);
#endif
}
```

```cpp
#include <hip/hip_runtime.h>
#include <hip/hip_cooperative_groups.h>
#include <cstdio>
#include <cstdint>
namespace cg = cooperative_groups;

#ifndef MK_MULTI
#define MK_MULTI 0
#endif

namespace pg8 {
#define PG8_LAS __attribute__((address_space(3)))
typedef unsigned short bf16_t;
typedef short bf16x8 __attribute__((ext_vector_type(8)));
typedef float f32x4 __attribute__((ext_vector_type(4)));
typedef unsigned u32x4 __attribute__((ext_vector_type(4)));
constexpr int BM = 256, BK = 64, HALF = 128, HTB = HALF * BK * 2  , STAGE_BYTES = 8 * HTB, NXCD = 8, WGM = 8;

__host__ __device__ __forceinline__ int lds_byte(int r, int c) { const int st = (r >> 4) * 2 + (c >> 5), rr = r & 15, cc = c & 31, ob = rr * 64 + cc * 2; return st * 1024 + (ob ^ (((ob >> 9) & 1) << 5)); }
__host__ __device__ __forceinline__ void stage_rc(int b, int& R, int& C) { const int st = b / 1024, sb = b % 1024, swz = sb ^ (((sb >> 9) & 1) << 5); R = (st >> 1) * 16 + swz / 64; C = (st & 1) * 32 + (swz % 64) / 2; }
__host__ __device__ __forceinline__ int perm32(int rho) { const int n = rho >> 4, i = rho & 15; return 8 * (i >> 2) + 4 * n + (i & 3); }

struct Unit { int pm, pn; };
struct Gemm { const bf16_t* A; const bf16_t* Bt; int M, N, K; };

struct StaticOrder {
    int nM, nN, nwg, G, c;
    __host__ __device__ void init(int M, int N, int G_, int c_) { nM = M / BM; nN = N / BM; nwg = nM * nN; G = G_; c = c_; }
    __host__ __device__ bool next(int i, Unit& u) const {
        const long L = (long)i * G + c; if (L >= nwg) return false;
        int wgid = (int)L; { const int q = nwg / NXCD, r = nwg % NXCD, xcd = wgid % NXCD, off = wgid / NXCD; wgid = (xcd < r ? xcd * (q + 1) : r * (q + 1) + (xcd - r) * q) + off; }
        const int nig = WGM * nN, gid = wgid / nig, fm = gid * WGM, gsz = (nM - fm) < WGM ? (nM - fm) : WGM;
        u.pm = fm + ((wgid % nig) % gsz); u.pn = (wgid % nig) / gsz; return true;
    }
    __device__ __forceinline__ void a_ready(const Unit&) const {}
    __device__ __forceinline__ void done(const Unit&) const {}
};


__device__ __forceinline__ unsigned cvt_pk_bf16(float lo, float hi) { unsigned r; asm volatile("v_cvt_pk_bf16_f32 %0, %1, %2" : "=v"(r) : "v"(lo), "v"(hi)); return r; }

struct EpiBf16 {
    static constexpr bool PERM = true, AFTER_DRAIN = false;
    bf16_t* O; int ldc;
    __device__ __forceinline__ void operator()(const f32x4 (&acc)[2][2][4][2], const Unit& u, int wr, int wc, int fr, int fq) const {
        const int row0 = u.pm * BM + wr * 64 + fr, col0 = u.pn * BM + wc * 32 + 8 * fq;
#pragma unroll
        for (int ai = 0; ai < 2; ++ai)
#pragma unroll
            for (int m = 0; m < 4; ++m) { bf16_t* rowp = O + (size_t)(row0 + ai * HALF + m * 16) * ldc + col0;
#pragma unroll
                for (int bj = 0; bj < 2; ++bj) { const f32x4 v0 = acc[ai][bj][m][0], v1 = acc[ai][bj][m][1];
                    u32x4 w; w.x = cvt_pk_bf16(v0[0], v0[1]); w.y = cvt_pk_bf16(v0[2], v0[3]); w.z = cvt_pk_bf16(v1[0], v1[1]); w.w = cvt_pk_bf16(v1[2], v1[3]);
                    *(u32x4*)(rowp + bj * HALF) = w; } }
    }
};

struct EpiF32 {
    static constexpr bool PERM = false, AFTER_DRAIN = false;
    float* O; int ldc;
    __device__ __forceinline__ void operator()(const f32x4 (&acc)[2][2][4][2], const Unit& u, int wr, int wc, int fr, int fq) const {
        const int row0 = u.pm * BM + wr * 64 + fr, col0 = u.pn * BM + wc * 32 + 4 * fq;
#pragma unroll
        for (int ai = 0; ai < 2; ++ai)
#pragma unroll
            for (int m = 0; m < 4; ++m) { float* rowp = O + (size_t)(row0 + ai * HALF + m * 16) * ldc + col0;
#pragma unroll
                for (int bj = 0; bj < 2; ++bj)
#pragma unroll
                    for (int n = 0; n < 2; ++n) *(f32x4*)(rowp + bj * HALF + n * 16) = acc[ai][bj][m][n]; }
    }
};

__device__ __forceinline__ float silu_f(float g) { return g * __builtin_amdgcn_rcpf(1.0f + __expf(-g)); }

struct EpiSwiGLU {
    static constexpr bool PERM = true, AFTER_DRAIN = false;
    bf16_t* O; int ldc;
    __device__ __forceinline__ void operator()(const f32x4 (&acc)[2][2][4][2], const Unit& u, int wr, int wc, int fr, int fq) const {
        const int row0 = u.pm * BM + wr * 64 + fr, col0 = u.pn * HALF + wc * 32 + 8 * fq;
#pragma unroll
        for (int ai = 0; ai < 2; ++ai)
#pragma unroll
            for (int m = 0; m < 4; ++m) {
                const f32x4 g0 = acc[ai][0][m][0], g1 = acc[ai][0][m][1], u0 = acc[ai][1][m][0], u1 = acc[ai][1][m][1];
                u32x4 w;
                w.x = cvt_pk_bf16(silu_f(g0[0]) * u0[0], silu_f(g0[1]) * u0[1]); w.y = cvt_pk_bf16(silu_f(g0[2]) * u0[2], silu_f(g0[3]) * u0[3]);
                w.z = cvt_pk_bf16(silu_f(g1[0]) * u1[0], silu_f(g1[1]) * u1[1]); w.w = cvt_pk_bf16(silu_f(g1[2]) * u1[2], silu_f(g1[3]) * u1[3]);
                *(u32x4*)(O + (size_t)(row0 + ai * HALF + m * 16) * ldc + col0) = w; }
    }
};

struct EpiProj {
    static constexpr bool PERM = true, AFTER_DRAIN = false;
    bf16_t* P; int ldc; float* gates; const float* cs; bf16_t* ikc;
    __device__ __forceinline__ void operator()(const f32x4 (&acc)[2][2][4][2], const Unit& u, int wr, int wc, int fr, int fq) const {
        const int row0 = u.pm * BM + wr * 64 + fr, pn = u.pn;
        const bool ropeT = (pn == 4 || pn == 5 || pn == 7);
        const float sg = (fq == 0) ? -1.0f : 1.0f;
#pragma unroll
        for (int ai = 0; ai < 2; ++ai)
#pragma unroll
            for (int m = 0; m < 4; ++m) {
                const int row = row0 + ai * HALF + m * 16;
#pragma unroll
                for (int bj = 0; bj < 2; ++bj) {
                    f32x4 v0 = acc[ai][bj][m][0], v1 = acc[ai][bj][m][1];
                    const bool rope = ((wc & 1) == 0) && (ropeT || (pn == 14 && bj == 0 && wc == 0));
                    if (rope) {
                        f32x4 p0, p1;
#pragma unroll
                        for (int i = 0; i < 4; ++i) { p0[i] = __shfl_xor(v0[i], 16); p1[i] = __shfl_xor(v1[i], 16); }
                        const f32x4 c0 = *(const f32x4*)(cs + (size_t)row * 16), c1 = *(const f32x4*)(cs + (size_t)row * 16 + 4);
                        const f32x4 s0 = *(const f32x4*)(cs + (size_t)row * 16 + 8), s1 = *(const f32x4*)(cs + (size_t)row * 16 + 12);
                        if (fq < 2) { v0 = v0 * c0 + sg * (p0 * s0); v1 = v1 * c1 + sg * (p1 * s1); }
                    }
                    u32x4 w; w.x = cvt_pk_bf16(v0[0], v0[1]); w.y = cvt_pk_bf16(v0[2], v0[3]); w.z = cvt_pk_bf16(v1[0], v1[1]); w.w = cvt_pk_bf16(v1[2], v1[3]);
                    *(u32x4*)(P + (size_t)row * ldc + pn * BM + bj * HALF + wc * 32 + 8 * fq) = w;
                    if (pn == 14 && bj == 0 && wc < 2) *(u32x4*)(ikc + ((size_t)(((row >> 4) * 2 + wc) * 4 + fq) * 16 + (row & 15)) * 8) = w;
                    if (pn == 14 && bj == 0 && wc == 2) { *(f32x4*)(gates + (size_t)row * 32 + 8 * fq) = v0; *(f32x4*)(gates + (size_t)row * 32 + 8 * fq + 4) = v1; }
                }
            }
    }
};

template <class Epi, class Sched, bool ALIGN_EPI = false, bool SP2 = false>
__device__ __forceinline__ void gemm_phase(PG8_LAS unsigned char* lds, const Gemm g, const Sched& S, const Epi& E, const int wave_id) {
    int tid_; asm volatile("v_mbcnt_lo_u32_b32 %0, -1, 0\n\tv_mbcnt_hi_u32_b32 %0, -1, %0" : "=v"(tid_)); tid_ += 64 * wave_id;
    const int tid = tid_, wid = __builtin_amdgcn_readfirstlane(tid >> 6), lane = tid & 63, wr = wid >> 2, wc = wid & 3, fr = lane & 15, fq = lane >> 4;
    const int K = g.K, nt = K / BK;
    unsigned voffA[2], voffB[2];
#pragma unroll
    for (int i = 0; i < 2; ++i) { int R, C; stage_rc(tid * 16 + i * 8192, R, C); const int Rb = Epi::PERM ? ((R & ~31) + perm32(R & 31)) : R;
        voffA[i] = (unsigned)(R * K + C) * 2u; voffB[i] = (unsigned)(Rb * K + C) * 2u; }
    const size_t kstep = (size_t)(BK * 2);
    const size_t hstep = (size_t)HALF * K * 2;
    const size_t tstep = 2 * hstep;
    const unsigned ldsw = (unsigned)wid * 1024u;
    const int aoff = lds_byte(wr * 64 + fr, fq * 8), boff = lds_byte(wc * 32 + fr, fq * 8);
#define PG8_SA(b, h) (((b) * 2 + (h)) * HTB)
#define PG8_SB(b, h) ((4 + (b) * 2 + (h)) * HTB)
#define PG8_STAGE(bufoff, gbase, voff) do { _Pragma("unroll") for (int _i = 0; _i < 2; ++_i) \
        __builtin_amdgcn_global_load_lds((const unsigned*)((const char*)(gbase) + (voff)[_i]), (PG8_LAS unsigned*)(lds + (bufoff) + ldsw + _i * 8192), 16, 0, 0); } while (0)
#define PG8_LDA(dst, b, h) do { _Pragma("unroll") for (int m = 0; m < 4; ++m) _Pragma("unroll") for (int k = 0; k < 2; ++k) dst[m][k] = *(const PG8_LAS bf16x8*)(lds + PG8_SA(b, h) + aoff + m * 2048 + k * 1024); } while (0)
#define PG8_LDB(dst, b, h) do { _Pragma("unroll") for (int n = 0; n < 2; ++n) _Pragma("unroll") for (int k = 0; k < 2; ++k) dst[n][k] = *(const PG8_LAS bf16x8*)(lds + PG8_SB(b, h) + boff + n * 2048 + k * 1024); } while (0)
#define PG8_MMA(ai, bj, At, Bt) do { __builtin_amdgcn_s_setprio(1); _Pragma("unroll") for (int m = 0; m < 4; ++m) _Pragma("unroll") for (int n = 0; n < 2; ++n) _Pragma("unroll") for (int k = 0; k < 2; ++k) \
        acc[ai][bj][m][n] = __builtin_amdgcn_mfma_f32_16x16x32_bf16(Bt[n][k], At[m][k], acc[ai][bj][m][n], 0, 0, 0); __builtin_amdgcn_s_setprio(0); } while (0)
#define PG8_WAIT_V(n) asm volatile("s_waitcnt vmcnt(" #n ")" ::: "memory")
#define PG8_WAIT_L(n) asm volatile("s_waitcnt lgkmcnt(" #n ")" ::: "memory")
#define PG8_BAR __builtin_amdgcn_s_barrier()
#define PG8_SCHED __builtin_amdgcn_sched_barrier(0)
    Unit cur, nxt; int ui = 0;
    if (!S.next(0, cur)) return;
    f32x4 acc[2][2][4][2];
#pragma unroll
    for (int a = 0; a < 2; ++a)
#pragma unroll
        for (int b = 0; b < 2; ++b)
#pragma unroll
            for (int m = 0; m < 4; ++m)
#pragma unroll
                for (int n = 0; n < 2; ++n) acc[a][b][m][n] = (f32x4){0.f, 0.f, 0.f, 0.f};
    bf16x8 At[4][2], B0[2][2], B1[2][2];
    const char* cA = (const char*)g.A + (size_t)cur.pm * tstep; const char* cB = (const char*)g.Bt + (size_t)cur.pn * tstep;
    S.a_ready(cur);
    if constexpr (SP2) {
        PG8_STAGE(PG8_SB(0, 0), cB, voffB); PG8_STAGE(PG8_SB(0, 1), cB + hstep, voffB); PG8_STAGE(PG8_SA(0, 0), cA, voffA); PG8_STAGE(PG8_SA(0, 1), cA + hstep, voffA);
        if (wr == 1) PG8_BAR;
        PG8_WAIT_V(2); PG8_BAR;
        PG8_STAGE(PG8_SB(1, 0), cB + kstep, voffB); PG8_STAGE(PG8_SA(1, 0), cA + kstep, voffA); PG8_STAGE(PG8_SB(1, 1), cB + hstep + kstep, voffB);
        PG8_WAIT_V(6); PG8_BAR;
    } else {
        PG8_STAGE(PG8_SB(0, 0), cB, voffB); PG8_STAGE(PG8_SA(0, 0), cA, voffA); PG8_STAGE(PG8_SB(0, 1), cB + hstep, voffB); PG8_STAGE(PG8_SA(0, 1), cA + hstep, voffA);
        if (wr == 1) PG8_BAR;
        PG8_WAIT_V(4); PG8_BAR;
        PG8_STAGE(PG8_SB(1, 0), cB + kstep, voffB); PG8_STAGE(PG8_SA(1, 0), cA + kstep, voffA); PG8_STAGE(PG8_SB(1, 1), cB + hstep + kstep, voffB);
        PG8_WAIT_V(6); PG8_BAR;
    }
    for (;;) {
        const bool has_next = S.next(ui + 1, nxt);
        const char* nA = has_next ? (const char*)g.A + (size_t)nxt.pm * tstep : cA; const char* nB = has_next ? (const char*)g.Bt + (size_t)nxt.pn * tstep : cB;
        for (int t = 0; t < nt; t += 2) {
            const bool last = (t == nt - 2);
            const char* a1 = cA + (size_t)(t + 1) * kstep;
            const char* a2 = last ? nA : cA + (size_t)(t + 2) * kstep; const char* b2 = last ? nB : cB + (size_t)(t + 2) * kstep;
            const char* a3 = a2 + kstep; const char* b3 = b2 + kstep;
            if (last && has_next) S.a_ready(nxt);
            if constexpr (SP2) {
            PG8_LDB(B0, 0, 0); PG8_LDB(B1, 0, 1); PG8_SCHED; PG8_LDA(At, 0, 0); PG8_STAGE(PG8_SA(1, 1), a1 + hstep, voffA);
            PG8_WAIT_V(8); PG8_WAIT_L(0); PG8_BAR; PG8_MMA(0, 0, At, B0); PG8_MMA(0, 1, At, B1); PG8_BAR; PG8_SCHED;
            PG8_LDA(At, 0, 1); PG8_STAGE(PG8_SB(0, 0), b2, voffB); PG8_STAGE(PG8_SB(0, 1), b2 + hstep, voffB); PG8_STAGE(PG8_SA(0, 0), a2, voffA);
            PG8_WAIT_V(8); PG8_WAIT_L(0); PG8_BAR; PG8_MMA(1, 0, At, B0); PG8_MMA(1, 1, At, B1); PG8_BAR; PG8_SCHED;
            PG8_LDB(B0, 1, 0); PG8_LDB(B1, 1, 1); PG8_SCHED; PG8_LDA(At, 1, 0); PG8_STAGE(PG8_SA(0, 1), a2 + hstep, voffA);
            PG8_WAIT_V(8); PG8_WAIT_L(0); PG8_BAR; PG8_MMA(0, 0, At, B0); PG8_MMA(0, 1, At, B1); PG8_BAR; PG8_SCHED;
            PG8_LDA(At, 1, 1); PG8_STAGE(PG8_SB(1, 0), b3, voffB); PG8_STAGE(PG8_SB(1, 1), b3 + hstep, voffB); PG8_STAGE(PG8_SA(1, 0), a3, voffA);
            PG8_WAIT_V(8); PG8_WAIT_L(0); PG8_BAR; PG8_MMA(1, 0, At, B0); PG8_MMA(1, 1, At, B1); PG8_BAR; PG8_SCHED;
            } else {
            PG8_LDB(B0, 0, 0); PG8_SCHED; PG8_LDA(At, 0, 0); PG8_STAGE(PG8_SA(1, 1), a1 + hstep, voffA);
            PG8_WAIT_L(8); PG8_BAR; PG8_WAIT_L(0); PG8_MMA(0, 0, At, B0); PG8_BAR; PG8_SCHED;
            PG8_LDB(B1, 0, 1); PG8_STAGE(PG8_SB(0, 0), b2, voffB);
            PG8_BAR; PG8_WAIT_L(0); PG8_MMA(0, 1, At, B1); PG8_BAR;
            PG8_LDA(At, 0, 1); PG8_STAGE(PG8_SA(0, 0), a2, voffA);
            PG8_BAR; PG8_WAIT_L(0); PG8_MMA(1, 0, At, B0); PG8_BAR; PG8_SCHED;
            PG8_STAGE(PG8_SB(0, 1), b2 + hstep, voffB);
            PG8_WAIT_V(6); PG8_BAR; PG8_MMA(1, 1, At, B1); PG8_BAR;
            PG8_LDB(B0, 1, 0); PG8_SCHED; PG8_LDA(At, 1, 0); PG8_STAGE(PG8_SA(0, 1), a2 + hstep, voffA);
            PG8_WAIT_L(8); PG8_BAR; PG8_WAIT_L(0); PG8_MMA(0, 0, At, B0); PG8_BAR; PG8_SCHED;
            PG8_LDB(B1, 1, 1); PG8_STAGE(PG8_SB(1, 0), b3, voffB);
            PG8_BAR; PG8_WAIT_L(0); PG8_MMA(0, 1, At, B1); PG8_BAR;
            PG8_LDA(At, 1, 1); PG8_STAGE(PG8_SA(1, 0), a3, voffA);
            PG8_BAR; PG8_WAIT_L(0); PG8_MMA(1, 0, At, B0); PG8_BAR; PG8_SCHED;
            PG8_STAGE(PG8_SB(1, 1), b3 + hstep, voffB);
            PG8_WAIT_V(6); PG8_BAR; PG8_MMA(1, 1, At, B1); PG8_BAR;
            }
        }
        if constexpr (ALIGN_EPI) { if (wr == 0) PG8_BAR; }
        if constexpr (!Epi::AFTER_DRAIN) { E(acc, cur, wr, wc, fr, fq); S.done(cur); }
        if (!has_next) break;
#pragma unroll
        for (int a = 0; a < 2; ++a)
#pragma unroll
            for (int b = 0; b < 2; ++b)
#pragma unroll
                for (int m = 0; m < 4; ++m)
#pragma unroll
                    for (int n = 0; n < 2; ++n) acc[a][b][m][n] = (f32x4){0.f, 0.f, 0.f, 0.f};
        cur = nxt; cA = nA; cB = nB; ++ui;
        if constexpr (ALIGN_EPI) { if (wr == 1) PG8_BAR; }
    }
    PG8_WAIT_V(0);
    if constexpr (!ALIGN_EPI) { if (wr == 0) PG8_BAR; }
    PG8_BAR;
    if constexpr (Epi::AFTER_DRAIN) { E.fused(acc, cur, wr, wc, fr, fq, lds, wid, lane); S.done(cur); }
#undef PG8_SA
#undef PG8_SB
#undef PG8_STAGE
#undef PG8_LDA
#undef PG8_LDB
#undef PG8_MMA
#undef PG8_WAIT_V
#undef PG8_WAIT_L
#undef PG8_BAR
#undef PG8_SCHED
}
}

#define LAS __attribute__((address_space(3)))
typedef unsigned short bf16_t;
typedef short bf16x8 __attribute__((ext_vector_type(8)));
typedef float f32x4 __attribute__((ext_vector_type(4)));
typedef unsigned u32x4 __attribute__((ext_vector_type(4)));
typedef unsigned u32x2 __attribute__((ext_vector_type(2)));

constexpr int SEQ = 16384, DM = 1024, NPROJ = 3840, LDP = 3904, DFF = 2816, NLAYER = 4, NIN = 3668;
constexpr int NWAVES = 8, NTHR = 512;
constexpr float EPSN = 1e-6f;
constexpr int PC_MQ = 0, PC_MK = 256, PC_MV = 512, PC_MO = 768, PC_AQ = 1024, PC_AK = 1280, PC_AV = 1536, PC_IQ = 1792, PC_SZ = 2048, PC_XBC = 2560, PC_IK = 3584;
constexpr int NPH = 1 + 9 * NLAYER;

constexpr size_t MiB = 1u << 20;
constexpr size_t WS_CTL = 0;
constexpr size_t WS_CS = 1 * MiB;
constexpr size_t WS_GATES = 2 * MiB;
constexpr size_t WS_SMALL = 4 * MiB;
constexpr size_t WS_WIN = 5 * MiB;
constexpr size_t WS_WOUT = WS_WIN + 3840ull * 1024 * 2;
constexpr size_t WS_WGU = WS_WOUT + 1024ull * 1024 * 2;
constexpr size_t WS_WDN = WS_WGU + 5632ull * 1024 * 2;
constexpr size_t WS_H = 32 * MiB;
constexpr size_t WS_MST = WS_H;
constexpr size_t WS_SEL = WS_H + 17 * MiB;
constexpr size_t WS_R2 = 64 * MiB;
constexpr size_t WS_MIX = WS_R2, WS_SST = WS_R2 + 32 * MiB;
constexpr size_t WS_R1 = 128 * MiB;
constexpr size_t WS_IKC = 250 * MiB;
constexpr size_t WS_END = 252 * MiB;
static_assert(WS_WDN + 1024ull * 2816 * 2 <= WS_H, "weights");
constexpr int SM_BLAST = 0, SM_MLOC = 1024, SM_M = 2048, SM_ALAST = 3072  , SM_SELCNT = 8192  ;

constexpr int LDS_BYTES = 147456;

struct Ctx {
    LAS unsigned char* lds; int tid, lane, wave, G, bid;
    const float* x_in; const int* pos; const float *norm_w, *w_in, *gate_b, *mnorm_w, *conv_w, *conv_b, *dt_bias, *a_log, *d_skip, *snorm_w, *w_out, *w_gate, *w_up, *w_down;
    float* out; unsigned char* ws;
};

__device__ __forceinline__ unsigned f2bf(float f) { unsigned u = __float_as_uint(f); return (u + 0x7fffu + ((u >> 16) & 1u)) >> 16; }
__device__ __forceinline__ float bf2f(unsigned h) { return __uint_as_float(h << 16); }
__device__ __forceinline__ unsigned pk2(float lo, float hi) { return f2bf(lo) | (f2bf(hi) << 16); }
__device__ __forceinline__ float bflo(unsigned w) { return __uint_as_float(w << 16); }
__device__ __forceinline__ float bfhi(unsigned w) { return __uint_as_float(w & 0xffff0000u); }
#define LDS_WAIT() asm volatile("s_waitcnt lgkmcnt(0)" ::: "memory")
__device__ __forceinline__ int opaque_v(int v) { asm volatile("" : "+v"(v)); return v; }
#define DPPF(v, ctrl) __builtin_bit_cast(float, __builtin_amdgcn_update_dpp(0, __builtin_bit_cast(int, (v)), ctrl, 0xF, 0xF, true))
__device__ __forceinline__ float row16_sum(float v) { v += DPPF(v, 0xB1); v += DPPF(v, 0x4E); v += DPPF(v, 0x141); v += DPPF(v, 0x140); return v; }
__device__ __forceinline__ float row16_max(float v) { v = fmaxf(v, DPPF(v, 0xB1)); v = fmaxf(v, DPPF(v, 0x4E)); v = fmaxf(v, DPPF(v, 0x141)); v = fmaxf(v, DPPF(v, 0x140)); return v; }
__device__ __forceinline__ float rl_f(float v, int l) { return __builtin_bit_cast(float, __builtin_amdgcn_readlane(__builtin_bit_cast(int, v), l)); }
__device__ __forceinline__ float wave_sum(float v) { v = row16_sum(v); return (rl_f(v, 0) + rl_f(v, 16)) + (rl_f(v, 32) + rl_f(v, 48)); }
__device__ __forceinline__ float wave_max(float v) { v = row16_max(v); return fmaxf(fmaxf(rl_f(v, 0), rl_f(v, 16)), fmaxf(rl_f(v, 32), rl_f(v, 48))); }
__device__ __forceinline__ float wave_scan_incl(float v, int lane) {
#pragma unroll
    for (int o = 1; o < 64; o <<= 1) { const float t = __builtin_bit_cast(float, __builtin_amdgcn_ds_bpermute(((lane - o) & 63) * 4, __builtin_bit_cast(int, v))); if (lane >= o) v += t; }
    return v;
}
__device__ __forceinline__ float lane_bcast(float v, int src) { return __builtin_bit_cast(float, __builtin_amdgcn_ds_bpermute(src * 4, __builtin_bit_cast(int, v))); }
__device__ __forceinline__ float xshfl_f(float v, int lane, int o) { return __builtin_bit_cast(float, __builtin_amdgcn_ds_bpermute((lane ^ o) * 4, __builtin_bit_cast(int, v))); }
__device__ __forceinline__ float softplus_f(float y) { return y > 20.0f ? y : log1pf(expf(y)); }
__device__ __forceinline__ float sigmoid_f(float z) { return __builtin_amdgcn_rcpf(1.0f + __expf(-z)); }

#define MFMA16(a, b, c) __builtin_amdgcn_mfma_f32_16x16x32_bf16(a, b, c, 0, 0, 0)
__device__ __forceinline__ bf16x8 ldN(const LAS bf16_t* base, int ld, int lane) { return *(const LAS bf16x8*)(base + (lane & 15) * ld + 8 * (lane >> 4)); }
__device__ __forceinline__ bf16x8 ldT(const LAS bf16_t* base, int ld, int lane) {
    const LAS bf16_t* p = base + (8 * (lane >> 4)) * ld + (lane & 15); bf16x8 v;
#pragma unroll
    for (int j = 0; j < 8; ++j) v[j] = (short)p[j * ld];
    return v;
}
__device__ __forceinline__ bf16x8 ones_frag(int lane) { const short o = (lane & 15) == 0 ? (short)0x3F80 : (short)0; return (bf16x8){o, o, o, o, o, o, o, o}; }
__device__ __forceinline__ f32x4 zero4() { return (f32x4){0.f, 0.f, 0.f, 0.f}; }

#define XB_TMO      128
#define XB_XCNT(j)  (256  + 64 * (j))
#define XB_XSUB(j)  (1280 + 64 * (j))
#define XB_XGEN(j)  (2304 + 64 * (j))
#define XB_TOP      3328
#define XB_TOPGEN   3392
#define XCD_BAR_WORDS 3456
#define XB_SPIN_CAP (1u << 18)

__device__ __forceinline__ unsigned xb_ld(unsigned* p)              { return __hip_atomic_load(p, __ATOMIC_RELAXED, __HIP_MEMORY_SCOPE_AGENT); }
__device__ __forceinline__ unsigned xb_add(unsigned* p, unsigned v) { return __hip_atomic_fetch_add(p, v, __ATOMIC_RELAXED, __HIP_MEMORY_SCOPE_AGENT); }
__device__ __forceinline__ unsigned xb_xcc_id() { return (unsigned)__builtin_amdgcn_s_getreg((3 << 11) | 20) & 0xFu; }
#define XB_SPIN(cond, bar) do { unsigned _sp = 0; while (cond) { __builtin_amdgcn_s_sleep(1); \
    if ((++_sp & 255u) == 0u) { if (xb_ld(&(bar)[XB_TMO])) break; if (_sp > XB_SPIN_CAP) { atomicAdd(&(bar)[XB_TMO], 1u); break; } } } } while (0)

struct XcdBarrier {
    unsigned* bar; unsigned x;
    volatile LAS unsigned* st;
};

__device__ __forceinline__ XcdBarrier xcd_barrier_post(unsigned* bar, volatile LAS unsigned* st, const bool is_t0) {
    XcdBarrier b; b.bar = bar; b.x = xb_xcc_id(); b.st = st;
    if (is_t0) (void)xb_add(&bar[XB_XCNT(b.x)], 1u);
    return b;
}
__device__ __forceinline__ void xcd_barrier_complete(unsigned* bar, unsigned x, unsigned& nloc, unsigned& nx) {
    const unsigned G = gridDim.x * gridDim.y * gridDim.z;
    unsigned sum, cnt, mine, sp = 0u;
    for (;;) {
        sum = 0u; cnt = 0u; mine = 0u;
#pragma unroll
        for (unsigned j = 0; j < 16; ++j) { const unsigned c = xb_ld(&bar[XB_XCNT(j)]); sum += c; cnt += (c > 0u) ? 1u : 0u; mine = (j == x) ? c : mine; }
        if (sum == G) break;
        __builtin_amdgcn_s_sleep(1);
        if ((++sp & 255u) == 0u) { if (xb_ld(&bar[XB_TMO])) break; if (sp > XB_SPIN_CAP) { atomicAdd(&bar[XB_TMO], 1u); break; } }
    }
    nloc = mine > 0u ? mine : 1u; nx = cnt > 0u ? cnt : 1u;
}

__device__ __forceinline__ void xcd_barrier(const XcdBarrier& b, const bool is_t0) {
    asm volatile("s_waitcnt vmcnt(0)" ::: "memory");
    __syncthreads();
    if (is_t0) {
        unsigned* bar = b.bar;
        __builtin_amdgcn_s_waitcnt(0);
        unsigned nloc = b.st[0], nx = b.st[1];
        if (nloc == 0u) { xcd_barrier_complete(bar, b.x, nloc, nx); b.st[0] = nloc; b.st[1] = nx; }
        const unsigned old = xb_add(&bar[XB_XSUB(b.x)], 1u);
        const unsigned gen = old / nloc;
        if (old + 1u == (gen + 1u) * nloc) {
            __builtin_amdgcn_fence(__ATOMIC_RELEASE, "agent");
            asm volatile("s_waitcnt vmcnt(0)" ::: "memory");
            const unsigned og = xb_add(&bar[XB_TOP], 1u);
            const unsigned tg = og / nx;
            if (og + 1u == (tg + 1u) * nx) xb_add(&bar[XB_TOPGEN], 1u);
            else XB_SPIN(xb_ld(&bar[XB_TOPGEN]) == tg, bar);
            __builtin_amdgcn_fence(__ATOMIC_ACQUIRE, "agent");
            xb_add(&bar[XB_XGEN(b.x)], 1u);
            asm volatile("s_waitcnt vmcnt(0)" ::: "memory");
        } else {
            XB_SPIN(xb_ld(&bar[XB_XGEN(b.x)]) == gen, bar);
            __builtin_amdgcn_fence(__ATOMIC_ACQUIRE, "agent");
            asm volatile("s_waitcnt vmcnt(0)" ::: "memory");
        }
    }
    __syncthreads();
}

#define XB_LSUB(j)  (3456 + 64 * (j))
#define XB_LGEN(j)  (4480 + 64 * (j))
__device__ __forceinline__ void xcd_local_sync(const XcdBarrier& b, const bool is_t0) {
    __syncthreads();
    if (is_t0) {
        unsigned* bar = b.bar;
        unsigned nloc = b.st[0], nx = b.st[1];
        if (nloc == 0u) { xcd_barrier_complete(bar, b.x, nloc, nx); b.st[0] = nloc; b.st[1] = nx; }
        const unsigned old = xb_add(&bar[XB_LSUB(b.x)], 1u);
        const unsigned gen = old / nloc;
        if (old + 1u == (gen + 1u) * nloc) xb_add(&bar[XB_LGEN(b.x)], 1u);
        else XB_SPIN(xb_ld(&bar[XB_LGEN(b.x)]) == gen, bar);
    }
    __syncthreads();
}

__device__ __forceinline__ void transpose_item(const float* colp4, int ldw, bf16_t* WT, int K, int n0, int k0, LAS float* scr, int lane) {
    f32x4 v[8];
#pragma unroll
    for (int i = 0; i < 8; ++i) v[i] = colp4 ? *(const f32x4*)(colp4 + (size_t)(k0 + 8 * i + (lane >> 3)) * ldw) : (f32x4){0.f, 0.f, 0.f, 0.f};
#pragma unroll
    for (int i = 0; i < 8; ++i) *(LAS f32x4*)(scr + (8 * i + (lane >> 3)) * 36 + 4 * (lane & 7)) = v[i];
    LDS_WAIT();
    const int c = lane & 7;
#pragma unroll
    for (int j = 0; j < 4; ++j) { const int n = (lane >> 3) + 8 * j; const LAS float* s = scr + (8 * c) * 36 + n;
        u32x4 o; o.x = pk2(s[0 * 36], s[1 * 36]); o.y = pk2(s[2 * 36], s[3 * 36]); o.z = pk2(s[4 * 36], s[5 * 36]); o.w = pk2(s[6 * 36], s[7 * 36]);
        *(u32x4*)(WT + (size_t)(n0 + n) * K + k0 + 8 * c) = o; }
    LDS_WAIT();
}
__device__ __forceinline__ int proj_src(int n) {
    if (n < 1024) return n;
    if (n < 1792) return n + 8;
    if (n < 2048) return 1800 + (n - 1792);
    if (n < 2560) return 2124 + (n - 2048);
    if (n < 3584) return 2636 + (n - 2560);
    if (n < 3648) return 2056 + (n - 3584);
    if (n < 3656) return 1024 + (n - 3648);
    if (n < 3660) return 2120 + (n - 3656);
    if (n < 3668) return n;
    return -1;
}
constexpr int CV_IN = 16 * 120, CV_OUT = CV_IN + 16 * 32, CV_GU = CV_OUT + 16 * 176, CV_ALL = CV_GU + 44 * 32;
__device__ __forceinline__ void convert_layer(const Ctx& X, int l, int it_lo, int it_hi, int wid, int nw) {
    LAS float* scr = (LAS float*)(X.lds + X.wave * 16384);
    const int gw = wid * NWAVES + X.wave, NGW = nw * NWAVES, lane = X.lane;
    bf16_t* WinT = (bf16_t*)(X.ws + WS_WIN); bf16_t* WoutT = (bf16_t*)(X.ws + WS_WOUT); bf16_t* WguT = (bf16_t*)(X.ws + WS_WGU); bf16_t* WdnT = (bf16_t*)(X.ws + WS_WDN);
    constexpr int I_IN = 16 * 120, I_OUT = 16 * 32, I_GU = 16 * 176, I_DN = 44 * 32, NIT = I_IN + I_OUT + I_GU + I_DN;
    for (int it = it_lo + gw; it < it_hi; it += NGW) {
        int r = it;
        if (r < I_IN) { const int kb = r / 120, nb = r % 120; const int src = proj_src(nb * 32 + 4 * (lane & 7));
            const float* colp = src >= 0 ? X.w_in + (size_t)l * 1024 * NIN + src : nullptr;
            transpose_item(colp, NIN, WinT, 1024, nb * 32, kb * 64, scr, lane); continue; }
        r -= I_IN;
        if (r < I_OUT) { const int kb = r / 32, nb = r % 32;
            transpose_item(X.w_out + (size_t)l * 1024 * 1024 + nb * 32 + 4 * (lane & 7), 1024, WoutT, 1024, nb * 32, kb * 64, scr, lane); continue; }
        r -= I_OUT;
        if (r < I_GU) { const int kb = r / 176, nb = r % 176; const int n = nb * 32 + 4 * (lane & 7), pn = n >> 8, rr = n & 255;
            const float* colp = (rr < 128 ? X.w_gate : X.w_up) + (size_t)l * 1024 * DFF + pn * 128 + (rr & 127);
            transpose_item(colp, DFF, WguT, 1024, nb * 32, kb * 64, scr, lane); continue; }
        r -= I_GU;
        { const int kb = r / 32, nb = r % 32;
            transpose_item(X.w_down + (size_t)l * DFF * 1024 + nb * 32 + 4 * (lane & 7), 1024, WdnT, DFF, nb * 32, kb * 64, scr, lane); }
    }
}
__device__ __forceinline__ void p0_prologue(const Ctx& X) {
    convert_layer(X, 0, 0, CV_OUT, X.bid, X.G); convert_layer(X, 0, CV_GU, CV_ALL, X.bid, X.G);
    float* cs = (float*)(X.ws + WS_CS);
    const float invf[8] = {1.0f, 0.1939227432012558f, 0.03760603070259094f, 0.007292664609849453f, 0.0014142135623842478f, 0.00027424818836152554f, 5.318296098266728e-05f, 1.0313386155758053e-05f};
    for (int g = X.bid * NTHR + X.tid; g < SEQ * 8; g += X.G * NTHR) {
        const int t = g >> 3, i = g & 7;
        float f = invf[0];
#pragma unroll
        for (int k = 1; k < 8; ++k) f = (i == k) ? invf[k] : f;
        const float ang = (float)X.pos[t] * f;
        double rev = (double)ang * 0.15915494309189535; rev -= rint(rev);
        const float fr = (float)rev;
        cs[t * 16 + i] = __builtin_amdgcn_cosf(fr); cs[t * 16 + 8 + i] = __builtin_amdgcn_sinf(fr);
    }
    const int gw = X.bid * NWAVES + X.wave, NGW = X.G * NWAVES, lane = X.lane;
    bf16_t* H = (bf16_t*)(X.ws + WS_H);
    for (int m = gw; m < SEQ; m += NGW) {
        const f32x4* xr = (const f32x4*)(X.x_in + (size_t)m * DM) + lane; f32x4 v[4]; float ss = 0.f;
#pragma unroll
        for (int j = 0; j < 4; ++j) { v[j] = xr[64 * j]; ss += (v[j].x * v[j].x + v[j].y * v[j].y) + (v[j].z * v[j].z + v[j].w * v[j].w); }
        const float r = rsqrtf(wave_sum(ss) * (1.0f / DM) + EPSN);
#pragma unroll
        for (int j = 0; j < 4; ++j) { const f32x4 w = ((const f32x4*)X.norm_w)[lane + 64 * j]; const f32x4 o = v[j] * r * w;
            u32x2 pk; pk.x = pk2(o.x, o.y); pk.y = pk2(o.z, o.w); *(u32x2*)(H + (size_t)m * DM + 4 * (lane + 64 * j)) = pk; }
    }
}

template <bool XF32IN, bool XF32OUT>
__device__ __forceinline__ void norm_phase(const Ctx& X, const bf16_t* src, const float* xsrc, const float* nwa, const float* nwb) {
    const int gw = X.bid * NWAVES + X.wave, NGW = X.G * NWAVES, lane = X.lane;
    bf16_t* H = (bf16_t*)(X.ws + WS_H);
    f32x4 wa[4], wb[4];
#pragma unroll
    for (int j = 0; j < 4; ++j) { wa[j] = ((const f32x4*)nwa)[lane + 64 * j]; wb[j] = nwb ? ((const f32x4*)nwb)[lane + 64 * j] : (f32x4){0.f, 0.f, 0.f, 0.f}; }
    constexpr int NR = XF32IN ? 4 : 8;
    for (int m0 = gw; m0 < SEQ; m0 += NR * NGW) {
        u32x2 sw[NR][4]; u32x2 xw[NR][4]; f32x4 xf[XF32IN ? NR : 1][4];
#pragma unroll
        for (int z = 0; z < NR; ++z) { const int m = (m0 + z * NGW < SEQ) ? m0 + z * NGW : m0;
            const u32x2* sr = (const u32x2*)(src + (size_t)m * DM) + lane; const f32x4* xr = (const f32x4*)(xsrc + (size_t)m * DM) + lane; const u32x2* xb = (const u32x2*)(xsrc + (size_t)m * DM) + lane;
#pragma unroll
            for (int j = 0; j < 4; ++j) { sw[z][j] = sr[64 * j];
                if (XF32IN) xf[XF32IN ? z : 0][j] = xr[64 * j]; else xw[z][j] = xb[64 * j]; } }
#pragma unroll
        for (int z = 0; z < NR; ++z) {
            const int m = m0 + z * NGW;
            if (m < SEQ) {
                f32x4 v[4], xv[4]; float ss = 0.f;
#pragma unroll
                for (int j = 0; j < 4; ++j) { const u32x2 w = sw[z][j]; v[j] = (f32x4){bflo(w.x), bfhi(w.x), bflo(w.y), bfhi(w.y)}; ss += (v[j].x * v[j].x + v[j].y * v[j].y) + (v[j].z * v[j].z + v[j].w * v[j].w);
                    if (XF32IN) xv[j] = xf[XF32IN ? z : 0][j]; else { const u32x2 q = xw[z][j]; xv[j] = (f32x4){bflo(q.x), bfhi(q.x), bflo(q.y), bfhi(q.y)}; } }
                const float r1 = rsqrtf(wave_sum(ss) * (1.0f / DM) + EPSN);
                float ss2 = 0.f;
#pragma unroll
                for (int j = 0; j < 4; ++j) { xv[j] = xv[j] + v[j] * r1 * wa[j];
                    ss2 += (xv[j].x * xv[j].x + xv[j].y * xv[j].y) + (xv[j].z * xv[j].z + xv[j].w * xv[j].w);
                    if (XF32OUT) ((f32x4*)(X.out + (size_t)m * DM))[lane + 64 * j] = xv[j];
                    else { u32x2 pk; pk.x = pk2(xv[j].x, xv[j].y); pk.y = pk2(xv[j].z, xv[j].w); ((u32x2*)(X.out + (size_t)m * DM))[lane + 64 * j] = pk; } }
                if (nwb) {
                    const float r2 = rsqrtf(wave_sum(ss2) * (1.0f / DM) + EPSN);
#pragma unroll
                    for (int j = 0; j < 4; ++j) { const f32x4 o = xv[j] * r2 * wb[j];
                        u32x2 pk; pk.x = pk2(o.x, o.y); pk.y = pk2(o.z, o.w); *(u32x2*)(H + (size_t)m * DM + 4 * (lane + 64 * j)) = pk; }
                }
            }
        }
    }
}

__device__ __forceinline__ void conv_rows4(const bf16_t* proj, const float* cw, const float* cb, int trow0, int ch0, float (&o)[4][8]) {
    float w[4][8], b[8];
#pragma unroll
    for (int j = 0; j < 4; ++j) { const f32x4 a = *(const f32x4*)(cw + j * 1024 + ch0), c = *(const f32x4*)(cw + j * 1024 + ch0 + 4);
        w[j][0] = a.x; w[j][1] = a.y; w[j][2] = a.z; w[j][3] = a.w; w[j][4] = c.x; w[j][5] = c.y; w[j][6] = c.z; w[j][7] = c.w; }
    { const f32x4 a = *(const f32x4*)(cb + ch0), c = *(const f32x4*)(cb + ch0 + 4); b[0] = a.x; b[1] = a.y; b[2] = a.z; b[3] = a.w; b[4] = c.x; b[5] = c.y; b[6] = c.z; b[7] = c.w; }
    u32x4 raw[7];
#pragma unroll
    for (int r = 0; r < 7; ++r) { const int t = trow0 - 3 + r;
        raw[r] = (t >= 0) ? *(const u32x4*)(proj + (size_t)t * LDP + PC_XBC + ch0) : (u32x4){0u, 0u, 0u, 0u}; }
#pragma unroll
    for (int r = 0; r < 4; ++r) {
        float acc[8];
#pragma unroll
        for (int e = 0; e < 8; ++e) acc[e] = b[e];
#pragma unroll
        for (int j = 0; j < 4; ++j) { const u32x4 q = raw[r + j];
            acc[0] += w[j][0] * bflo(q.x); acc[1] += w[j][1] * bfhi(q.x); acc[2] += w[j][2] * bflo(q.y); acc[3] += w[j][3] * bfhi(q.y);
            acc[4] += w[j][4] * bflo(q.z); acc[5] += w[j][5] * bfhi(q.z); acc[6] += w[j][6] * bflo(q.w); acc[7] += w[j][7] * bfhi(q.w); }
#pragma unroll
        for (int e = 0; e < 8; ++e) o[r][e] = acc[e] * sigmoid_f(acc[e]);
    }
}
__device__ __forceinline__ u32x4 pack8(const float (&v)[8], float sc) {
    u32x4 w; w.x = pk2(v[0] * sc, v[1] * sc); w.y = pk2(v[2] * sc, v[3] * sc); w.z = pk2(v[4] * sc, v[5] * sc); w.w = pk2(v[6] * sc, v[7] * sc); return w;
}
__device__ __forceinline__ u32x4 scale8(u32x4 q, float sc) {
    u32x4 w; w.x = pk2(bflo(q.x) * sc, bfhi(q.x) * sc); w.y = pk2(bflo(q.y) * sc, bfhi(q.y) * sc); w.z = pk2(bflo(q.z) * sc, bfhi(q.z) * sc); w.w = pk2(bflo(q.w) * sc, bfhi(q.w) * sc); return w;
}

__device__ __forceinline__ void b1_chunk(const Ctx& X, int l, int c) {
    const int tid = opaque_v(X.tid), lane = tid & 63, wave = X.wave, t0 = c * 64;
    const bf16_t* proj = (const bf16_t*)(X.ws + WS_R1); const float* gates = (const float*)(X.ws + WS_GATES);
    float* small = (float*)(X.ws + WS_SMALL);
    {
        LAS bf16_t* Xs = (LAS bf16_t*)(X.lds);
        LAS bf16_t* Bm = (LAS bf16_t*)(X.lds + 66560);
        LAS float* sW = (LAS float*)(X.lds + 66560 + 33792);
        {
            const int h = wave; const float dtb = X.dt_bias[l * 8 + h], A = -expf(X.a_log[l * 8 + h]);
            const float dt = softplus_f(gates[(size_t)(t0 + lane) * 32 + 12 + h] + dtb);
            const float ac = wave_scan_incl(dt * A, lane); const float alast = rl_f(ac, 63);
            sW[h * 64 + lane] = expf(alast - ac) * dt;
            if (lane == 63) small[SM_ALAST + c * 8 + h] = alast;
        }
        __syncthreads();
        const float* cw = X.conv_w + (size_t)l * 4 * 1024; const float* cb = X.conv_b + (size_t)l * 1024;
        for (int idx = tid; idx < 96 * 16; idx += NTHR) {
            const int cgp = idx % 96, rb = idx / 96, ch0 = cgp * 8;
            float o[4][8]; conv_rows4(proj, cw, cb, t0 + 4 * rb, ch0, o);
#pragma unroll
            for (int r = 0; r < 4; ++r) { const int row = 4 * rb + r;
                if (ch0 < 512) { const float sc = sW[(ch0 >> 6) * 64 + row]; *(LAS u32x4*)(Xs + row * 520 + ch0) = pack8(o[r], sc); }
                else *(LAS u32x4*)(Bm + row * 264 + (ch0 - 512)) = pack8(o[r], 1.0f); }
        }
        __syncthreads();
        {
            const int h = wave, g = h >> 2;
            bf16_t* dst = (bf16_t*)(X.ws + WS_SST) + (size_t)(c * 8 + h) * 64 * 128;
#pragma unroll 1
            for (int nh = 0; nh < 2; ++nh) {
                f32x4 acc[4][4];
#pragma unroll
                for (int mi = 0; mi < 4; ++mi)
#pragma unroll
                    for (int ni = 0; ni < 4; ++ni) acc[mi][ni] = zero4();
#pragma unroll
                for (int ks = 0; ks < 2; ++ks) {
                    bf16x8 af[4], bfr[4];
#pragma unroll
                    for (int mi = 0; mi < 4; ++mi) af[mi] = ldT(Xs + (32 * ks) * 520 + h * 64 + 16 * mi, 520, lane);
#pragma unroll
                    for (int ni = 0; ni < 4; ++ni) bfr[ni] = ldT(Bm + (32 * ks) * 264 + g * 128 + nh * 64 + 16 * ni, 264, lane);
#pragma unroll
                    for (int mi = 0; mi < 4; ++mi)
#pragma unroll
                        for (int ni = 0; ni < 4; ++ni) acc[mi][ni] = MFMA16(bfr[ni], af[mi], acc[mi][ni]);
                }
#pragma unroll
                for (int mi = 0; mi < 4; ++mi)
#pragma unroll
                    for (int ni = 0; ni < 4; ++ni) { u32x2 o; o.x = pk2(acc[mi][ni][0], acc[mi][ni][1]); o.y = pk2(acc[mi][ni][2], acc[mi][ni][3]);
                        *(u32x2*)(dst + (16 * mi + (lane & 15)) * 128 + nh * 64 + 16 * ni + 4 * (lane >> 4)) = o; }
            }
        }
        __syncthreads();
    }
    {
        LAS bf16_t* Kw = (LAS bf16_t*)(X.lds);
        LAS bf16_t* Vm = (LAS bf16_t*)(X.lds + 33792);
        LAS float* sWm = (LAS float*)(X.lds + 67584);
        if (wave < 4) {
            const int h = wave;
            const float ipre = gates[(size_t)(t0 + lane) * 32 + h] + X.gate_b[l * 8 + h];
            const float fpre = gates[(size_t)(t0 + lane) * 32 + 4 + h] + X.gate_b[l * 8 + 4 + h];
            const float lf = -softplus_f(-fpre);
            const float b = wave_scan_incl(lf, lane); const float blast = rl_f(b, 63);
            const float logw = blast - b + ipre; const float mloc = wave_max(logw);
            sWm[h * 64 + lane] = expf(logw - mloc);
            if (lane == 0) { small[SM_BLAST + c * 4 + h] = blast; small[SM_MLOC + c * 4 + h] = mloc; }
        }
        __syncthreads();
#pragma unroll
        for (int i = 0; i < 8; ++i) {
            const int idx = tid + NTHR * i, mat = idx >> 11, rem = idx & 2047, row = rem >> 5, ch = (rem & 31) * 8;
            u32x4 v = *(const u32x4*)(proj + (size_t)(t0 + row) * LDP + (mat ? PC_MV : PC_MK) + ch);
            if (!mat) v = scale8(v, sWm[(ch >> 6) * 64 + row]);
            *(LAS u32x4*)((mat ? Vm : Kw) + row * 264 + ch) = v;
        }
        __syncthreads();
        {
            const int hh = wave >> 1, dh = wave & 1;
            f32x4 acc[5][2];
#pragma unroll
            for (int ei = 0; ei < 5; ++ei) { acc[ei][0] = zero4(); acc[ei][1] = zero4(); }
#pragma unroll
            for (int ks = 0; ks < 2; ++ks) {
                bf16x8 af[5], bfr[2];
#pragma unroll
                for (int ei = 0; ei < 4; ++ei) af[ei] = ldT(Vm + (32 * ks) * 264 + hh * 64 + 16 * ei, 264, lane);
                af[4] = ones_frag(lane);
#pragma unroll
                for (int ni = 0; ni < 2; ++ni) bfr[ni] = ldT(Kw + (32 * ks) * 264 + hh * 64 + dh * 32 + 16 * ni, 264, lane);
#pragma unroll
                for (int ei = 0; ei < 5; ++ei)
#pragma unroll
                    for (int ni = 0; ni < 2; ++ni) acc[ei][ni] = MFMA16(bfr[ni], af[ei], acc[ei][ni]);
            }
            float* dst = (float*)(X.ws + WS_MST) + (size_t)(c * 4 + hh) * 65 * 64;
#pragma unroll
            for (int ei = 0; ei < 5; ++ei)
#pragma unroll
                for (int ni = 0; ni < 2; ++ni) { const int e = 16 * ei + (lane & 15); if (e <= 64) *(f32x4*)(dst + e * 64 + dh * 32 + 16 * ni + 4 * (lane >> 4)) = acc[ei][ni]; }
        }
        __syncthreads();
    }
}

__device__ __forceinline__ unsigned mono_u(unsigned u) { return (u & 0x80000000u) ? ~u : (u | 0x80000000u); }
__device__ __forceinline__ unsigned unmono_u(unsigned k) { return (k & 0x80000000u) ? (k & 0x7fffffffu) : ~k; }
#define DPP_STEP(v, op, ctrl) op(v, __builtin_amdgcn_update_dpp(0, (int)(v), ctrl, 0xF, 0xF, true))
__device__ __forceinline__ int iadd_(int a, int b) { return a + b; }
__device__ __forceinline__ unsigned umax_(unsigned a, int b) { return a > (unsigned)b ? a : (unsigned)b; }
__device__ __forceinline__ unsigned umin_(unsigned a, int b) { return a < (unsigned)b ? a : (unsigned)b; }
__device__ __forceinline__ int wave_sum_u(int v) {
    v = DPP_STEP(v, iadd_, 0xB1); v = DPP_STEP(v, iadd_, 0x4E); v = DPP_STEP(v, iadd_, 0x141); v = DPP_STEP(v, iadd_, 0x140);
    return __builtin_amdgcn_readlane(v, 0) + __builtin_amdgcn_readlane(v, 16) + __builtin_amdgcn_readlane(v, 32) + __builtin_amdgcn_readlane(v, 48);
}
__device__ __forceinline__ unsigned wave_max_u(unsigned v) {
    v = DPP_STEP(v, umax_, 0xB1); v = DPP_STEP(v, umax_, 0x4E); v = DPP_STEP(v, umax_, 0x141); v = DPP_STEP(v, umax_, 0x140);
    const unsigned a = (unsigned)__builtin_amdgcn_readlane((int)v, 0), b = (unsigned)__builtin_amdgcn_readlane((int)v, 16), c = (unsigned)__builtin_amdgcn_readlane((int)v, 32), d = (unsigned)__builtin_amdgcn_readlane((int)v, 48);
    const unsigned ab = a > b ? a : b, cd = c > d ? c : d; return ab > cd ? ab : cd;
}
__device__ __forceinline__ unsigned wave_min_u(unsigned v) {
    v = DPP_STEP(v, umin_, 0xB1); v = DPP_STEP(v, umin_, 0x4E); v = DPP_STEP(v, umin_, 0x141); v = DPP_STEP(v, umin_, 0x140);
    const unsigned a = (unsigned)__builtin_amdgcn_readlane((int)v, 0), b = (unsigned)__builtin_amdgcn_readlane((int)v, 16), c = (unsigned)__builtin_amdgcn_readlane((int)v, 32), d = (unsigned)__builtin_amdgcn_readlane((int)v, 48);
    const unsigned ab = a < b ? a : b, cd = c < d ? c : d; return ab < cd ? ab : cd;
}
constexpr int PRUNE_SLACK = 128;
__device__ __forceinline__ int suffix_sum64(int h, int lane) {
    int S = h;
    S += __builtin_amdgcn_update_dpp(0, S, 0x101, 0xF, 0xF, true); S += __builtin_amdgcn_update_dpp(0, S, 0x102, 0xF, 0xF, true);
    S += __builtin_amdgcn_update_dpp(0, S, 0x104, 0xF, 0xF, true); S += __builtin_amdgcn_update_dpp(0, S, 0x108, 0xF, 0xF, true);
    const int r1 = __builtin_amdgcn_readlane(S, 16), r2 = __builtin_amdgcn_readlane(S, 32), r3 = __builtin_amdgcn_readlane(S, 48);
    const int row = lane >> 4;
    return S + (row == 0 ? r1 + r2 + r3 : (row == 1 ? r2 + r3 : (row == 2 ? r3 : 0)));
}
__device__ __forceinline__ void topk_prune(LAS u32x2* cq, int n, LAS int* cntq, LAS float* thrq, LAS int* hist, bool final, int lane, bool dry = false) {
    unsigned sk[16], ix[16];
    unsigned vmax = 0u, vmin = 0xFFFFFFFFu;
#pragma unroll
    for (int i = 0; i < 16; ++i) { const int idx = lane + 64 * i; const u32x2 e = cq[idx]; const bool ok = idx < n; const unsigned m = mono_u(e.x);
        sk[i] = ok ? m : 0u; ix[i] = ok ? e.y : 0xFFFFFFFFu; const unsigned mm = ok ? m : 0xFFFFFFFFu;
        vmin = mm < vmin ? mm : vmin; vmax = sk[i] > vmax ? sk[i] : vmax; }
    const unsigned kmax = wave_max_u(vmax), kmin = wave_min_u(vmin);
    unsigned T = kmax; bool split = false;
    int need = 256, ties = n;
    if (kmax != kmin) {
        int bitpos = 32 - __clz((int)(kmax ^ kmin));
        T = bitpos == 32 ? 0u : ((kmax >> bitpos) << bitpos);
#pragma unroll 1
        while (bitpos > 0) {
            const int w = bitpos >= 8 ? 8 : bitpos, sh = bitpos - w;
            *(LAS u32x4*)(hist + 4 * lane) = (u32x4){0u, 0u, 0u, 0u};
            LDS_WAIT();
#pragma unroll
            for (int i = 0; i < 16; ++i) {
                const bool in = (lane + 64 * i < n) && (bitpos == 32 || (sk[i] >> bitpos) == (T >> bitpos));
                const unsigned bin = in ? ((sk[i] >> sh) & ((1u << w) - 1u)) : (unsigned)(256 + lane);
                __hip_atomic_fetch_add(&hist[bin], 1, __ATOMIC_RELAXED, __HIP_MEMORY_SCOPE_WORKGROUP);
            }
            LDS_WAIT();
            const u32x4 h4 = *(const LAS u32x4*)(hist + 4 * lane);
            const int hs = (int)(h4.x + h4.y + h4.z + h4.w);
            const int S = suffix_sum64(hs, lane);
            const unsigned long long m = __ballot(S >= need);
            const int Ld = 63 - __clzll(m);
            const int hv[4] = {__builtin_amdgcn_readlane((int)h4.x, Ld), __builtin_amdgcn_readlane((int)h4.y, Ld), __builtin_amdgcn_readlane((int)h4.z, Ld), __builtin_amdgcn_readlane((int)h4.w, Ld)};
            int c = __builtin_amdgcn_readlane(S, Ld) - __builtin_amdgcn_readlane(hs, Ld);
            int d = 4 * Ld, hd = hv[0], Sd;
            if (c + hv[3] >= need) { d += 3; hd = hv[3]; Sd = c + hv[3]; }
            else if (c + hv[3] + hv[2] >= need) { d += 2; hd = hv[2]; Sd = c + hv[3] + hv[2]; }
            else if (c + hv[3] + hv[2] + hv[1] >= need) { d += 1; hd = hv[1]; Sd = c + hv[3] + hv[2] + hv[1]; }
            else { Sd = c + hv[3] + hv[2] + hv[1] + hv[0]; }
            need -= Sd - hd; ties = hd;
            T |= (unsigned)d << sh; bitpos = sh;
            if (need == hd || (!final && hd <= PRUNE_SLACK)) { split = true; break; }
        }
    }
    unsigned Ilim = 0xFFFFFFFFu;
    if (!split && need < ties) {
        unsigned I = 0u;
#pragma unroll 1
        for (int bit = 13; bit >= 0; --bit) {
            const unsigned cnd = I | (1u << bit); int c = 0;
#pragma unroll
            for (int i = 0; i < 16; ++i) c += (sk[i] == T && ix[i] < cnd) ? 1 : 0;
            if (wave_sum_u(c) < need) I = cnd;
        }
        Ilim = I;
    }
    if (dry) { if (T == 0x13579bdu && Ilim == 77u) *thrq = 0.f; return; }
    int base = 0;
#pragma unroll
    for (int i = 0; i < 16; ++i) {
        const bool kp = (sk[i] > T) || (sk[i] == T && ix[i] <= Ilim);
        const unsigned long long mk = __ballot(kp);
        const int pos = base + __popcll(mk & ((1ull << lane) - 1ull));
        LAS u32x2* dst = kp ? (cq + pos) : ((LAS u32x2*)(hist + 320) + lane);
        *dst = (u32x2){unmono_u(sk[i]), ix[i]};
        base += __popcll(mk);
    }
    if (lane == 0) { *cntq = base; *thrq = __uint_as_float(unmono_u(split && T != 0u ? T - 1u : T)); }
}
__device__ __forceinline__ void write_sorted(const LAS u32x2* cq, int n, LAS unsigned* bm, unsigned short* out, int lane) {
#pragma unroll
    for (int k = 0; k < 8; ++k) bm[lane + 64 * k] = 0u;
    LDS_WAIT();
    unsigned idx[4];
#pragma unroll
    for (int k = 0; k < 4; ++k) { const int i = lane + 64 * k; idx[k] = cq[i < n ? i : 0].y;
        __hip_atomic_fetch_or(&bm[idx[k] >> 5], 1u << (idx[k] & 31), __ATOMIC_RELAXED, __HIP_MEMORY_SCOPE_WORKGROUP); }
    LDS_WAIT();
    unsigned w[8]; int c = 0;
    { const u32x4 a_ = *(const LAS u32x4*)(bm + lane * 8), b_ = *(const LAS u32x4*)(bm + lane * 8 + 4);
      w[0] = a_.x; w[1] = a_.y; w[2] = a_.z; w[3] = a_.w; w[4] = b_.x; w[5] = b_.y; w[6] = b_.z; w[7] = b_.w; }
#pragma unroll
    for (int k = 0; k < 8; ++k) c += __popc(w[k]);
    int incl = c;
#pragma unroll
    for (int o = 1; o < 64; o <<= 1) { const int t = __builtin_amdgcn_ds_bpermute(((lane - o) & 63) * 4, incl); if (lane >= o) incl += t; }
    unsigned pre[8]; { int p = incl - c;
#pragma unroll
      for (int k = 0; k < 8; ++k) { pre[k] = (unsigned)p; p += __popc(w[k]); } }
    LAS unsigned* wp = bm + 512;
    *(LAS u32x4*)(wp + lane * 8) = (u32x4){pre[0], pre[1], pre[2], pre[3]}; *(LAS u32x4*)(wp + lane * 8 + 4) = (u32x4){pre[4], pre[5], pre[6], pre[7]};
    LDS_WAIT();
    unsigned rank[4];
#pragma unroll
    for (int k = 0; k < 4; ++k) { const unsigned wd = idx[k] >> 5, bw = bm[wd], pw = wp[wd]; rank[k] = pw + (unsigned)__popc(bw & ((1u << (idx[k] & 31)) - 1u)); }
    asm volatile("" : "+v"(rank[0]), "+v"(rank[1]), "+v"(rank[2]), "+v"(rank[3]));
#pragma unroll
    for (int k = 0; k < 4; ++k) if (lane + 64 * k < n) out[rank[k]] = (unsigned short)idx[k];
    LDS_WAIT();
}
constexpr int CCAP = 1024, CAND_BYTES = 16 * CCAP * 8;
constexpr int IDX_CTL = 131072;
constexpr int SAMPLE_RANK = 112, SAMPLE_EVERY = 4, ZT_TARGET = 600;
__device__ __forceinline__ void idx_mfma(const bf16x8 (&af)[4][2], const bf16x8 (&kf)[2][2], f32x4 (&acc)[2][4]) {
#pragma unroll
    for (int s2 = 0; s2 < 2; ++s2)
#pragma unroll
        for (int mt = 0; mt < 4; ++mt) { acc[s2][mt] = MFMA16(af[mt][0], kf[s2][0], zero4()); acc[s2][mt] = MFMA16(af[mt][1], kf[s2][1], acc[s2][mt]); }
}
__device__ __forceinline__ void idx_post(const f32x4 (&acc)[2][4], const float (&wq)[4][4], const float (&th)[4], const int (&kl)[4], const int kmin,
                                         const int kb_, const int t0, const int lane, const int wave, const int pass, LAS unsigned* hst, LAS int* cnt, LAS u32x2* cand) {
    const bool diag = kb_ + 255 >= kmin;
    float sc[2][4];
#pragma unroll
    for (int s2 = 0; s2 < 2; ++s2)
#pragma unroll
        for (int mt = 0; mt < 4; ++mt) {
            const float r0 = __int_as_float(max(__float_as_int(acc[s2][mt][0]), 0)), r1 = __int_as_float(max(__float_as_int(acc[s2][mt][1]), 0));
            const float r2 = __int_as_float(max(__float_as_int(acc[s2][mt][2]), 0)), r3 = __int_as_float(max(__float_as_int(acc[s2][mt][3]), 0));
            sc[s2][mt] = __builtin_fmaf(wq[mt][3], r3, __builtin_fmaf(wq[mt][2], r2, __builtin_fmaf(wq[mt][1], r1, __builtin_fmaf(wq[mt][0], r0, 0.0f))));
        }
    if (pass == 0) {
        if (!diag) {
#pragma unroll
            for (int s2 = 0; s2 < 2; ++s2)
#pragma unroll
                for (int mt = 0; mt < 4; ++mt) { const int q = 4 * mt + (lane >> 4); const unsigned bin = mono_u(__float_as_uint(sc[s2][mt])) >> 20;
                    __hip_atomic_fetch_add(&hst[q * 2048 + (bin >> 1)], 1u << (16 * (bin & 1u)), __ATOMIC_RELAXED, __HIP_MEMORY_SCOPE_WORKGROUP); }
        } else {
#pragma unroll
            for (int s2 = 0; s2 < 2; ++s2) {
                const int key = kb_ + s2 * 128 + wave * 16 + (lane & 15);
#pragma unroll
                for (int mt = 0; mt < 4; ++mt) { const int q = 4 * mt + (lane >> 4);
                    if (key < kl[mt]) { const unsigned bin = mono_u(__float_as_uint(sc[s2][mt])) >> 20;
                        __hip_atomic_fetch_add(&hst[q * 2048 + (bin >> 1)], 1u << (16 * (bin & 1u)), __ATOMIC_RELAXED, __HIP_MEMORY_SCOPE_WORKGROUP); } }
            }
        }
        return;
    }
    if (diag) {
#pragma unroll
        for (int s2 = 0; s2 < 2; ++s2) {
            const int key = kb_ + s2 * 128 + wave * 16 + (lane & 15);
#pragma unroll
            for (int mt = 0; mt < 4; ++mt) sc[s2][mt] = (key < kl[mt]) ? sc[s2][mt] : -INFINITY;
        }
    }
    {
        int pos[2][4]; unsigned long long sv_, mk[2][4];
        const unsigned cnt_a = (unsigned)(uintptr_t)(cnt + (lane >> 4)); const int one_ = 1;
#pragma unroll
        for (int s2 = 0; s2 < 2; ++s2)
            asm volatile("v_cmp_gt_f32 %[m0], %[sc0], %[th0]\n\tv_cmp_gt_f32 %[m1], %[sc1], %[th1]\n\tv_cmp_gt_f32 %[m2], %[sc2], %[th2]\n\tv_cmp_gt_f32 %[m3], %[sc3], %[th3]\n\t"
                         "s_mov_b64 %[sv], exec\n\t"
                         "s_mov_b64 exec, %[m0]\n\tds_add_rtn_u32 %[p0], %[ad], %[one]\n\t"
                         "s_mov_b64 exec, %[m1]\n\tds_add_rtn_u32 %[p1], %[ad], %[one] offset:16\n\t"
                         "s_mov_b64 exec, %[m2]\n\tds_add_rtn_u32 %[p2], %[ad], %[one] offset:32\n\t"
                         "s_mov_b64 exec, %[m3]\n\tds_add_rtn_u32 %[p3], %[ad], %[one] offset:48\n\t"
                         "s_mov_b64 exec, %[sv]"
                         : [p0]"=&v"(pos[s2][0]), [p1]"=&v"(pos[s2][1]), [p2]"=&v"(pos[s2][2]), [p3]"=&v"(pos[s2][3]),
                           [m0]"=&s"(mk[s2][0]), [m1]"=&s"(mk[s2][1]), [m2]"=&s"(mk[s2][2]), [m3]"=&s"(mk[s2][3]), [sv]"=&s"(sv_)
                         : [sc0]"v"(sc[s2][0]), [sc1]"v"(sc[s2][1]), [sc2]"v"(sc[s2][2]), [sc3]"v"(sc[s2][3]), [th0]"v"(th[0]), [th1]"v"(th[1]), [th2]"v"(th[2]), [th3]"v"(th[3]),
                           [ad]"v"(cnt_a), [one]"v"(one_) : "memory");
        asm volatile("s_waitcnt lgkmcnt(0)" : "+v"(pos[0][0]), "+v"(pos[0][1]), "+v"(pos[0][2]), "+v"(pos[0][3]), "+v"(pos[1][0]), "+v"(pos[1][1]), "+v"(pos[1][2]), "+v"(pos[1][3]) :: "memory");
        const unsigned lb_ = (unsigned)(uintptr_t)(cand + (lane >> 4) * CCAP);
#pragma unroll
        for (int s2 = 0; s2 < 2; ++s2) {
            const unsigned key = (unsigned)(kb_ + s2 * 128 + wave * 16 + (lane & 15));
            unsigned a0_, a1_, a2_, a3_;
            asm volatile("v_and_b32 %[a0], 0x3ff, %[p0]\n\tv_and_b32 %[a1], 0x3ff, %[p1]\n\tv_and_b32 %[a2], 0x3ff, %[p2]\n\tv_and_b32 %[a3], 0x3ff, %[p3]\n\t"
                         "v_lshl_add_u32 %[a0], %[a0], 3, %[l0]\n\tv_lshl_add_u32 %[a1], %[a1], 3, %[l1]\n\tv_lshl_add_u32 %[a2], %[a2], 3, %[l2]\n\tv_lshl_add_u32 %[a3], %[a3], 3, %[l3]\n\t"
                         "s_mov_b64 %[sv], exec\n\t"
                         "s_mov_b64 exec, %[m0]\n\tds_write2_b32 %[a0], %[sc0], %[key] offset1:1\n\t"
                         "s_mov_b64 exec, %[m1]\n\tds_write2_b32 %[a1], %[sc1], %[key] offset1:1\n\t"
                         "s_mov_b64 exec, %[m2]\n\tds_write2_b32 %[a2], %[sc2], %[key] offset1:1\n\t"
                         "s_mov_b64 exec, %[m3]\n\tds_write2_b32 %[a3], %[sc3], %[key] offset1:1\n\t"
                         "s_mov_b64 exec, %[sv]"
                         : [sv]"=&s"(sv_), [a0]"=&v"(a0_), [a1]"=&v"(a1_), [a2]"=&v"(a2_), [a3]"=&v"(a3_)
                         : [m0]"s"(mk[s2][0]), [m1]"s"(mk[s2][1]), [m2]"s"(mk[s2][2]), [m3]"s"(mk[s2][3]),
                           [p0]"v"(pos[s2][0]), [p1]"v"(pos[s2][1]), [p2]"v"(pos[s2][2]), [p3]"v"(pos[s2][3]),
                           [l0]"v"(lb_), [l1]"v"(lb_ + 1 * (4 * CCAP * 8)), [l2]"v"(lb_ + 2 * (4 * CCAP * 8)), [l3]"v"(lb_ + 3 * (4 * CCAP * 8)),
                           [sc0]"v"(sc[s2][0]), [sc1]"v"(sc[s2][1]), [sc2]"v"(sc[s2][2]), [sc3]"v"(sc[s2][3]), [key]"v"(key) : "memory");
        }
    }
}
__device__ __forceinline__ void idx_window(const bf16x8 (&af)[4][2], const float (&wq)[4][4], const float (&th)[4], const int (&kl)[4], const int kmin, const bf16x8 (&kf)[2][2],
                                           const int kb_, const int t0, const int lane, const int wave, const int pass, LAS unsigned* hst, LAS int* cnt, LAS u32x2* cand) {
    f32x4 acc[2][4]; idx_mfma(af, kf, acc); idx_post(acc, wq, th, kl, kmin, kb_, t0, lane, wave, pass, hst, cnt, cand);
}
struct IdxKeys { const char* base; unsigned loff; int wmul; };
__device__ __forceinline__ void idx_load(bf16x8 (&kf)[2][2], const IdxKeys kb0, int win) {
    const char* kb = kb0.base + (size_t)(win * kb0.wmul) * (256 * 128);
    kf[0][0] = *(const bf16x8*)(kb + kb0.loff); kf[0][1] = *(const bf16x8*)(kb + 1024 + kb0.loff);
    kf[1][0] = *(const bf16x8*)(kb + 128 * 128 + kb0.loff); kf[1][1] = *(const bf16x8*)(kb + 128 * 128 + 1024 + kb0.loff);
}
__device__ __forceinline__ void idx_aload(bf16x8 (&kf)[2][2], const IdxKeys kb0, int win) {
    const char* kb = kb0.base + (size_t)(win * kb0.wmul) * (256 * 128); const char* kb1 = kb + 128 * 128;
    asm volatile("s_nop 4\n\tglobal_load_dwordx4 %0, %4, %5\n\tglobal_load_dwordx4 %1, %4, %5 offset:1024\n\tglobal_load_dwordx4 %2, %4, %6\n\tglobal_load_dwordx4 %3, %4, %6 offset:1024"
                 : "=&v"(kf[0][0]), "=&v"(kf[0][1]), "=&v"(kf[1][0]), "=&v"(kf[1][1]) : "v"(kb0.loff), "s"(kb), "s"(kb1) : "memory");
}
#define IDX_AWAIT(kf, n) asm volatile("s_waitcnt vmcnt(" #n ")" : "+v"(kf[0][0]), "+v"(kf[0][1]), "+v"(kf[1][0]), "+v"(kf[1][1]) :: "memory")
__device__ __forceinline__ void idx_stream_begin(bf16x8 (&k0)[2][2], bf16x8 (&k1)[2][2], bf16x8 (&k2)[2][2], const IdxKeys kb0, const int nwin, const int wstep) {
    const int nit = (nwin + wstep - 1) / wstep, lastw = (nit - 1) * wstep;
    idx_aload(k0, kb0, 0); idx_aload(k1, kb0, min(wstep, lastw)); idx_aload(k2, kb0, min(2 * wstep, lastw));
}
__device__ __forceinline__ void idx_stream_drain(bf16x8 (&k0)[2][2], bf16x8 (&k1)[2][2], bf16x8 (&k2)[2][2]) { asm volatile("s_waitcnt vmcnt(0)" ::: "memory"); }
__device__ __forceinline__ void idx_stream(bf16x8 (&k0)[2][2], bf16x8 (&k1)[2][2], bf16x8 (&k2)[2][2],
                                           const bf16x8 (&af)[4][2], const float (&wq)[4][4], const float (&th)[4], const int (&kl)[4], const int kmin, const IdxKeys kb0, const int nwin, const int wstep,
                                           const int t0, const int lane, const int wave, const int pass, LAS unsigned* hst, LAS int* cnt, LAS u32x2* cand) {
    const int nit = (nwin + wstep - 1) / wstep, lastw = (nit - 1) * wstep;
    bf16x8 k3[2][2];
#pragma unroll
    for (int mt = 0; mt < 4; ++mt) asm volatile("" :: "v"(af[mt][0]), "v"(af[mt][1]), "v"(wq[mt][0]), "v"(wq[mt][1]), "v"(wq[mt][2]), "v"(wq[mt][3]));
    f32x4 aA[2][4], aB[2][4];
    IDX_AWAIT(k0, 8); idx_mfma(af, k0, aA);
#pragma unroll 1
    for (int it = 0; it < nit; it += 4) {
        const int w = it * wstep;
        idx_aload(k3, kb0, min(w + 3 * wstep, lastw)); IDX_AWAIT(k1, 8);
        idx_mfma(af, k1, aB); __builtin_amdgcn_sched_barrier(0);
        idx_post(aA, wq, th, kl, kmin, w * 256, t0, lane, wave, pass, hst, cnt, cand);
        idx_aload(k0, kb0, min(w + 4 * wstep, lastw)); IDX_AWAIT(k2, 8);
        idx_mfma(af, k2, aA); __builtin_amdgcn_sched_barrier(0);
        if (it + 1 < nit) idx_post(aB, wq, th, kl, kmin, (w + wstep) * 256, t0, lane, wave, pass, hst, cnt, cand);
        idx_aload(k1, kb0, min(w + 5 * wstep, lastw)); IDX_AWAIT(k3, 8);
        idx_mfma(af, k3, aB); __builtin_amdgcn_sched_barrier(0);
        if (it + 2 < nit) idx_post(aA, wq, th, kl, kmin, (w + 2 * wstep) * 256, t0, lane, wave, pass, hst, cnt, cand);
        idx_aload(k2, kb0, min(w + 6 * wstep, lastw)); IDX_AWAIT(k0, 8);
        idx_mfma(af, k0, aA); __builtin_amdgcn_sched_barrier(0);
        if (it + 3 < nit) idx_post(aB, wq, th, kl, kmin, (w + 3 * wstep) * 256, t0, lane, wave, pass, hst, cnt, cand);
    }
    IDX_AWAIT(k0, 0); IDX_AWAIT(k1, 0); IDX_AWAIT(k2, 0); IDX_AWAIT(k3, 0);
    LDS_WAIT();
}
__device__ __forceinline__ void dsa_index_item(const Ctx& X, int item) {
    const int tid = opaque_v(X.tid), lane = tid & 63, wave = X.wave, t0 = item * 16;
    const bf16_t* proj = (const bf16_t*)(X.ws + WS_R1); const float* gates = (const float*)(X.ws + WS_GATES);
    LAS u32x2* cand = (LAS u32x2*)X.lds;
    LAS unsigned* hst = (LAS unsigned*)X.lds;
    LAS int* cnt = (LAS int*)(X.lds + IDX_CTL); LAS float* thr = (LAS float*)(X.lds + IDX_CTL + 64);
    LAS int* flag3 = (LAS int*)(X.lds + IDX_CTL + 128); LAS int* failf = (LAS int*)(X.lds + IDX_CTL + 144);
    LAS int* cge = (LAS int*)(X.lds + IDX_CTL + 192);
    LAS int* hist = (LAS int*)(X.lds + IDX_CTL + 256 + wave * 1792);
    LAS int* klim = (LAS int*)(X.lds + IDX_CTL + 14720);
    unsigned short* sel = (unsigned short*)(X.ws + WS_SEL); int* selcnt = (int*)(X.ws + WS_SMALL) + SM_SELCNT;
    bf16x8 af[4][2]; float wq[4][4];
#pragma unroll
    for (int mt = 0; mt < 4; ++mt) {
        const bf16_t* b = proj + (size_t)(t0 + 4 * mt + ((lane & 15) >> 2)) * LDP + PC_IQ + 64 * (lane & 3) + 8 * (lane >> 4);
        af[mt][0] = *(const bf16x8*)b; af[mt][1] = *(const bf16x8*)(b + 32);
        const f32x4 w4 = *(const f32x4*)(gates + (size_t)(t0 + 4 * mt + (lane >> 4)) * 32 + 8);
        wq[mt][0] = w4.x; wq[mt][1] = w4.y; wq[mt][2] = w4.z; wq[mt][3] = w4.w;
    }
    const int nwin = (t0 + 15) / 256 + 1;
    const IdxKeys kb0{(const char*)(X.ws + WS_IKC) + wave * 2048, (unsigned)lane * 16u, 1};
    const int q0 = wave * 2;
    bf16x8 k0[2][2], k1[2][2], k2[2][2];
    if (t0 >= 1024) idx_stream_begin(k0, k1, k2, kb0, nwin, SAMPLE_EVERY);
    const f32x4 wv0 = *(const f32x4*)(gates + (size_t)(t0 + q0) * 32 + 8), wv1 = *(const f32x4*)(gates + (size_t)(t0 + q0 + 1) * 32 + 8);
    bool done = false, failed = false;
    int kl[4]; int kmin = t0 + 1;
#pragma unroll
    for (int mt = 0; mt < 4; ++mt) kl[mt] = t0 + 4 * mt + (lane >> 4) + 1;
    if (tid < 16) { cnt[tid] = 0; thr[tid] = -INFINITY; cge[tid] = 0; klim[tid] = t0 + tid + 1; }
    if (tid == 16) failf[0] = 0;
    if (t0 >= 1024) {
#pragma unroll
        for (int i = 0; i < 16; ++i) ((LAS u32x4*)X.lds)[tid + NTHR * i] = (u32x4){0u, 0u, 0u, 0u};
        float th[4] = {-INFINITY, -INFINITY, -INFINITY, -INFINITY};
        __syncthreads();
        idx_stream(k0, k1, k2, af, wq, th, kl, kmin, kb0, nwin, SAMPLE_EVERY, t0, lane, wave, 0, hst, cnt, cand);
        __syncthreads();
        asm volatile("" :: "v"(wv0), "v"(wv1));
        idx_stream_begin(k0, k1, k2, kb0, nwin, 1);
#pragma unroll 1
        for (int qq = 0; qq < 2; ++qq) {
            const int q = q0 + qq; const LAS unsigned* hq = hst + q * 2048;
            int s = 0;
#pragma unroll
            for (int i = 0; i < 8; ++i) { const u32x4 v = *(const LAS u32x4*)(hq + 32 * lane + 4 * i);
                s += (int)((v.x & 0xffffu) + (v.x >> 16) + (v.y & 0xffffu) + (v.y >> 16)) + (int)((v.z & 0xffffu) + (v.z >> 16) + (v.w & 0xffffu) + (v.w >> 16)); }
            const int S = suffix_sum64(s, lane);
            const int total = __builtin_amdgcn_readlane(S, 0);
            if (total >= SAMPLE_RANK) {
                const int Ls = 63 - __clzll(__ballot(S >= SAMPLE_RANK));
                const int above = __builtin_amdgcn_readlane(S - s, Ls), need = SAMPLE_RANK - above;
                const unsigned wd = hq[32 * Ls + (lane >> 1)]; const int cb = (int)((wd >> (16 * (lane & 1))) & 0xffffu);
                const int S2 = suffix_sum64(cb, lane);
                const int bj = 63 - __clzll(__ballot(S2 >= need));
                const unsigned edge = (unsigned)(64 * Ls + bj) << 20;
                const float thr0 = __uint_as_float(edge == 0x80000000u ? 0x80000001u : unmono_u(edge - 1u));
                int cq = above + __builtin_amdgcn_readlane(S2, bj);
                const f32x4 wv = qq ? wv1 : wv0;
                const int cz = __builtin_amdgcn_readlane(cb, bj);
                if (edge == 0x80000000u && above == 0 && wv.x <= 0.f && wv.y <= 0.f && wv.z <= 0.f && wv.w <= 0.f && SAMPLE_EVERY * cz > ZT_TARGET) {
                    const int kcut = (int)(((long long)total * ZT_TARGET) / cz);
                    if (lane == 0) klim[q] = min(t0 + q + 1, max(kcut, 1024));
                    cq = ZT_TARGET / SAMPLE_EVERY;
                }
                if (lane == 0) { thr[q] = thr0; cge[q] = cq; }
            }
        }
        __syncthreads();
        int mxc = 0;
#pragma unroll
        for (int i = 0; i < 16; ++i) mxc = max(mxc, cge[i]);
        const bool fits = SAMPLE_EVERY * mxc <= 800;
#pragma unroll
        for (int mt = 0; mt < 4; ++mt) { th[mt] = thr[4 * mt + (lane >> 4)]; kl[mt] = klim[4 * mt + (lane >> 4)]; }
#pragma unroll
        for (int i = 0; i < 16; ++i) kmin = min(kmin, klim[i]);
        __syncthreads();
        if (!fits) idx_stream_drain(k0, k1, k2);
        if (fits) {
            idx_stream(k0, k1, k2, af, wq, th, kl, kmin, kb0, nwin, 1, t0, lane, wave, 1, hst, cnt, cand);
            __syncthreads();
            if (lane == 0 && (cnt[q0] > CCAP || cnt[q0] < 256 || cnt[q0 + 1] > CCAP || cnt[q0 + 1] < 256)) failf[0] = 1;
            __syncthreads();
            if (failf[0] == 0) {
#pragma unroll 1
                for (int qq = 0; qq < 2; ++qq) {
                    const int q = q0 + qq; int n = cnt[q];
#if defined(PROBE_SUB) && PROBE_SUB == 35
                    if (n > 256) { topk_prune(cand + q * CCAP, n, cnt + q, thr + q, hist, true, lane, true); LDS_WAIT(); }
#endif
                    if (n > 256) { topk_prune(cand + q * CCAP, n, cnt + q, thr + q, hist, true, lane); LDS_WAIT(); n = cnt[q]; }
                    LDS_WAIT();
#if defined(PROBE_SUB) && PROBE_SUB == 36
                    write_sorted(cand + q * CCAP, n, (LAS unsigned*)(cand + q * CCAP + 512), sel + (size_t)(t0 + q) * 256, lane);
#endif
                    write_sorted(cand + q * CCAP, n, (LAS unsigned*)(cand + q * CCAP + 512), sel + (size_t)(t0 + q) * 256, lane);
                    if (lane == 0) selcnt[t0 + q] = n;
                }
                done = true;
            } else failed = true;
        }
        __syncthreads();
        if (!done && tid < 16) { cnt[tid] = 0; if (failed) thr[tid] = -INFINITY; }
#pragma unroll
        for (int mt = 0; mt < 4; ++mt) kl[mt] = t0 + 4 * mt + (lane >> 4) + 1;
        kmin = t0 + 1;
    }
    if (!done) {
        if (tid < 3) flag3[tid] = 0;
        float th[4];
        __syncthreads();
#pragma unroll
        for (int mt = 0; mt < 4; ++mt) th[mt] = thr[4 * mt + (lane >> 4)];
        bf16x8 cur[2][2], nxt[2][2];
        idx_load(cur, kb0, 0);
#pragma unroll 1
        for (int w = 0; w < nwin; ++w) {
            const bool last = (w == nwin - 1);
            idx_load(nxt, kb0, min(w + 1, nwin - 1));
            idx_window(af, wq, th, kl, kmin, cur, w * 256, t0, lane, wave, 1, hst, cnt, cand);
            LDS_WAIT();
            __syncthreads();
            const int trig = (cnt[q0] > CCAP - 256 || cnt[q0 + 1] > CCAP - 256) ? 1 : 0;
            const int ck = w % 3;
            if (tid == 0) flag3[(ck + 1) % 3] = 0;
            if (trig && lane == 0) flag3[ck] = 1;
            __syncthreads();
            const int anyt = flag3[ck];
            if (anyt || last) {
#pragma unroll 1
                for (int qq = 0; qq < 2; ++qq) {
                    const int q = q0 + qq; int n = cnt[q];
                    if (n > 256 + PRUNE_SLACK || (last && n > 256)) { topk_prune(cand + q * CCAP, n, cnt + q, thr + q, hist, last, lane); LDS_WAIT(); n = cnt[q]; }
                    if (last) {
                        LDS_WAIT();
                        write_sorted(cand + q * CCAP, n, (LAS unsigned*)(cand + q * CCAP + 512), sel + (size_t)(t0 + q) * 256, lane);
                        if (lane == 0) selcnt[t0 + q] = n;
                    }
                }
                __syncthreads();
#pragma unroll
                for (int mt = 0; mt < 4; ++mt) th[mt] = thr[4 * mt + (lane >> 4)];
            }
#pragma unroll
            for (int s4 = 0; s4 < 2; ++s4) { cur[s4][0] = nxt[s4][0]; cur[s4][1] = nxt[s4][1]; }
        }
    }
    __syncthreads();
}

__device__ __forceinline__ void b2_scan(const Ctx& X) {
    float* small = (float*)(X.ws + WS_SMALL);
    const int NT = X.G * NTHR;
    for (int g = X.bid * NTHR + X.tid; g < 65536 + 16640; g += NT) {
        if (g < 65536) {
            const int h = g >> 13; bf16_t* p = (bf16_t*)(X.ws + WS_SST) + g; float st = 0.f;
#pragma unroll 8
            for (int c = 0; c < 256; ++c) { const float dec = __expf(small[SM_ALAST + c * 8 + h]); const float loc = bf2f(p[(size_t)c * 65536]);
                p[(size_t)c * 65536] = (bf16_t)f2bf(st); st = st * dec + loc; }
        } else {
            const int q = g - 65536, h = q / 4160; float* p = (float*)(X.ws + WS_MST) + q; float st = 0.f, m = 0.f; const bool wr = (q % 4160) == 0;
#pragma unroll 8
            for (int c = 0; c < 256; ++c) {
                const float bl = small[SM_BLAST + c * 4 + h], ml = small[SM_MLOC + c * 4 + h];
                const float mn = fmaxf(bl + m, ml); const float dec = __expf(bl + m - mn), isc = __expf(ml - mn);
                if (wr) small[SM_M + c * 4 + h] = m;
                const float loc = p[(size_t)c * 16640]; p[(size_t)c * 16640] = st; st = st * dec + isc * loc; m = mn; }
        }
    }
}

__device__ __forceinline__ bf16x8 cvt_frag_f32(const float* p, bool ok) {
    u32x4 w = (u32x4){0u, 0u, 0u, 0u};
    if (ok) { const f32x4 a = *(const f32x4*)p, b = *(const f32x4*)(p + 4); w.x = pk2(a.x, a.y); w.y = pk2(a.z, a.w); w.z = pk2(b.x, b.y); w.w = pk2(b.z, b.w); }
    return __builtin_bit_cast(bf16x8, w);
}
__device__ __forceinline__ void b3_chunk(const Ctx& X, int l, int c) {
    const int wave = X.wave, t0 = c * 64;
    const bf16_t* proj = (const bf16_t*)(X.ws + WS_R1); const float* gates = (const float*)(X.ws + WS_GATES);
    const float* small = (const float*)(X.ws + WS_SMALL);
    bf16_t* mix = (bf16_t*)(X.ws + WS_MIX);
    const int hs = wave >> 1, rh = wave & 1;
    {
        const int tid = opaque_v(X.tid), lane = tid & 63, lr = lane & 15, lq = lane >> 4, h = hs;
#pragma unroll
        for (int i = 0; i < 4; ++i) { const int idx = tid + NTHR * i, sh = idx >> 9, r2 = idx & 511, row = r2 >> 3, ch = (r2 & 7) * 8;
            *(LAS u32x4*)(X.lds + sh * 18944 + (row * 72 + ch) * 2) = *(const u32x4*)(proj + (size_t)(t0 + row) * LDP + PC_MV + sh * 64 + ch); }
        if (rh == 0) {
            const float ipre = gates[(size_t)(t0 + lane) * 32 + h] + X.gate_b[l * 8 + h];
            const float fpre = gates[(size_t)(t0 + lane) * 32 + 4 + h] + X.gate_b[l * 8 + 4 + h];
            const float b = wave_scan_incl(-softplus_f(-fpre), lane);
            ((LAS float*)(X.lds + hs * 18944 + 18432))[lane] = b; ((LAS float*)(X.lds + hs * 18944 + 18688))[lane] = ipre;
        }
        bf16x8 qf[2][2], kf[4][2], cf[5][2];
#pragma unroll
        for (int tt = 0; tt < 2; ++tt)
#pragma unroll
            for (int ks = 0; ks < 2; ++ks) qf[tt][ks] = *(const bf16x8*)(proj + (size_t)(t0 + 32 * rh + 16 * tt + lr) * LDP + PC_MQ + h * 64 + 32 * ks + 8 * lq);
#pragma unroll
        for (int ni = 0; ni < 4; ++ni)
#pragma unroll
            for (int ks = 0; ks < 2; ++ks) kf[ni][ks] = *(const bf16x8*)(proj + (size_t)(t0 + 16 * ni + lr) * LDP + PC_MK + h * 64 + 32 * ks + 8 * lq);
        const float* ctg = (const float*)(X.ws + WS_MST) + (size_t)(c * 4 + h) * 4160;
#pragma unroll
        for (int ei = 0; ei < 5; ++ei)
#pragma unroll
            for (int ks = 0; ks < 2; ++ks) cf[ei][ks] = cvt_frag_f32(ctg + (16 * ei + lr) * 64 + 32 * ks + 8 * lq, 16 * ei + lr <= 64);
        const float mc = small[SM_M + c * 4 + h];
        __syncthreads();
        const LAS bf16_t* V = (const LAS bf16_t*)(X.lds + hs * 18944); LAS bf16_t* Sm = (LAS bf16_t*)(X.lds + hs * 18944 + 9216);
        const LAS float* sB = (const LAS float*)(X.lds + hs * 18944 + 18432); const LAS float* sI = (const LAS float*)(X.lds + hs * 18944 + 18688);
#pragma unroll
        for (int tt = 0; tt < 2; ++tt) {
            const int t = 32 * rh + 16 * tt + lr, nmax = 2 * rh + tt;
            const float bt = sB[t];
            f32x4 sacc[4], ldv[4]; float mx = -INFINITY;
#pragma unroll
            for (int ni = 0; ni < 4; ++ni) if (ni <= nmax) {
                sacc[ni] = zero4();
#pragma unroll
                for (int ks = 0; ks < 2; ++ks) sacc[ni] = MFMA16(kf[ni][ks], qf[tt][ks], sacc[ni]);
                const f32x4 b4 = *(const LAS f32x4*)(sB + 16 * ni + 4 * lq), i4 = *(const LAS f32x4*)(sI + 16 * ni + 4 * lq);
#pragma unroll
                for (int j = 0; j < 4; ++j) { ldv[ni][j] = (16 * ni + 4 * lq + j <= t) ? (bt - b4[j] + i4[j]) : -INFINITY; mx = fmaxf(mx, ldv[ni][j]); }
            }
            mx = fmaxf(mx, xshfl_f(mx, lane, 16)); mx = fmaxf(mx, xshfl_f(mx, lane, 32));
            const float mt = fmaxf(bt + mc, mx);
#pragma unroll
            for (int ni = 0; ni < 4; ++ni) {
                u32x2 pk = (u32x2){0u, 0u};
                if (ni <= nmax) { float v[4];
#pragma unroll
                    for (int j = 0; j < 4; ++j) v[j] = (16 * ni + 4 * lq + j <= t) ? sacc[ni][j] * 0.125f * __expf(ldv[ni][j] - mt) : 0.0f;
                    pk.x = pk2(v[0], v[1]); pk.y = pk2(v[2], v[3]); }
                *(LAS u32x2*)(Sm + t * 72 + 16 * ni + 4 * lq) = pk;
            }
            const float scl = __expf(bt + mc - mt) * 0.125f, emt = __expf(-mt);
            LDS_WAIT();
            f32x4 num[5];
#pragma unroll
            for (int ei = 0; ei < 5; ++ei) { f32x4 na = zero4(), ca = zero4();
#pragma unroll
                for (int ks = 0; ks < 2; ++ks) {
                    const bf16x8 av = (ei < 4) ? ldT(V + (32 * ks) * 72 + 16 * ei, 72, lane) : ones_frag(lane);
                    na = MFMA16(av, ldN(Sm + (32 * rh + 16 * tt) * 72 + 32 * ks, 72, lane), na);
                    ca = MFMA16(cf[ei][ks], qf[tt][ks], ca); }
                num[ei] = na + ca * scl; }
            const float den = lane_bcast(num[4][0], lr);
            const float inv = 1.0f / fmaxf(fabsf(den), emt);
            float ss = 0.f;
#pragma unroll
            for (int ei = 0; ei < 4; ++ei) { num[ei] = num[ei] * inv; ss += (num[ei][0] * num[ei][0] + num[ei][1] * num[ei][1]) + (num[ei][2] * num[ei][2] + num[ei][3] * num[ei][3]); }
            ss += xshfl_f(ss, lane, 16); ss += xshfl_f(ss, lane, 32);
            const float r = rsqrtf(ss * (1.0f / 64.0f) + EPSN);
#pragma unroll
            for (int ei = 0; ei < 4; ++ei) { const int e0 = 16 * ei + 4 * lq;
                const f32x4 w = *(const f32x4*)(X.mnorm_w + l * 256 + h * 64 + e0);
                const u32x2 mo = *(const u32x2*)(proj + (size_t)(t0 + t) * LDP + PC_MO + h * 64 + e0);
                u32x2 o; o.x = pk2(num[ei][0] * r * w.x * sigmoid_f(bflo(mo.x)), num[ei][1] * r * w.y * sigmoid_f(bfhi(mo.x)));
                o.y = pk2(num[ei][2] * r * w.z * sigmoid_f(bflo(mo.y)), num[ei][3] * r * w.w * sigmoid_f(bfhi(mo.y)));
                *(u32x2*)(mix + (size_t)(t0 + t) * DM + h * 64 + e0) = o; }
        }
        __syncthreads();
    }
    const float* cw = X.conv_w + (size_t)l * 4 * 1024; const float* cb = X.conv_b + (size_t)l * 1024;
#pragma unroll 1
    for (int g = 0; g < 2; ++g) {
        const int tid = opaque_v(X.tid), lane = tid & 63, lr = lane & 15, lq = lane >> 4, h = 4 * g + hs;
        LAS bf16_t* Cm = (LAS bf16_t*)(X.lds);
        LAS bf16_t* Bm = (LAS bf16_t*)(X.lds + 17408);
        LAS float* Gs = (LAS float*)(X.lds + 34816);
        LAS bf16_t* Pm = (LAS bf16_t*)(X.lds + 52224 + hs * 18432);
        LAS bf16_t* Xh = (LAS bf16_t*)(X.lds + 52224 + hs * 18432 + 9216);
        LAS float* sDt = (LAS float*)(X.lds + 125952);
        LAS float* sAc = (LAS float*)(X.lds + 126976);
        LAS float* ssq = (LAS float*)(X.lds + 128000);
        if (wave < 4) {
            const int hh = 4 * g + wave; const float dtb = X.dt_bias[l * 8 + hh], A = -expf(X.a_log[l * 8 + hh]);
            const float dt = softplus_f(gates[(size_t)(t0 + lane) * 32 + 12 + hh] + dtb);
            const float ac = wave_scan_incl(dt * A, lane);
            sDt[wave * 64 + lane] = dt; sAc[wave * 64 + lane] = ac;
        }
        {
            const int rb = tid >> 5, cgp = tid & 31, mat = cgp >> 4, chl = (cgp & 15) * 8;
            float o[4][8]; conv_rows4(proj, cw, cb, t0 + 4 * rb, 512 + mat * 256 + g * 128 + chl, o);
#pragma unroll
            for (int r = 0; r < 4; ++r) *(LAS u32x4*)((mat ? Cm : Bm) + (4 * rb + r) * 136 + chl) = pack8(o[r], 1.0f);
        }
        {
            const int rb = tid >> 5, ch = (tid & 31) * 8, sh = ch >> 6;
            float o[4][8]; conv_rows4(proj, cw, cb, t0 + 4 * rb, g * 256 + ch, o);
#pragma unroll
            for (int r = 0; r < 4; ++r) *(LAS u32x4*)(X.lds + 52224 + sh * 18432 + 9216 + ((4 * rb + r) * 72 + (ch & 63)) * 2) = pack8(o[r], 1.0f);
        }
        bf16x8 sf[4][4];
        const bf16_t* stg = (const bf16_t*)(X.ws + WS_SST) + (size_t)(c * 8 + h) * 64 * 128;
#pragma unroll
        for (int pi = 0; pi < 4; ++pi)
#pragma unroll
            for (int ks = 0; ks < 4; ++ks) sf[pi][ks] = *(const bf16x8*)(stg + (16 * pi + lr) * 128 + 32 * ks + 8 * lq);
        __syncthreads();
        {
            const int ti = wave >> 1;
#pragma unroll
            for (int sj = 0; sj < 2; ++sj) { const int si = 2 * (wave & 1) + sj; f32x4 acc = zero4();
#pragma unroll
                for (int ks = 0; ks < 4; ++ks) acc = MFMA16(ldN(Bm + 16 * si * 136 + 32 * ks, 136, lane), ldN(Cm + 16 * ti * 136 + 32 * ks, 136, lane), acc);
                *(LAS f32x4*)(Gs + (16 * ti + lr) * 68 + 16 * si + 4 * lq) = acc; }
        }
        __syncthreads();
        const float dsk = X.d_skip[l * 8 + h];
        f32x4 gat[2][4];
#pragma unroll
        for (int tt = 0; tt < 2; ++tt) {
            const int t = 32 * rh + 16 * tt + lr, nmax = 2 * rh + tt;
            const float at = sAc[hs * 64 + t];
#pragma unroll
            for (int ni = 0; ni < 4; ++ni) {
                u32x2 pk = (u32x2){0u, 0u};
                if (ni <= nmax) { const int s0 = 16 * ni + 4 * lq;
                    const f32x4 g4 = *(const LAS f32x4*)(Gs + t * 68 + s0), a4 = *(const LAS f32x4*)(sAc + hs * 64 + s0), d4 = *(const LAS f32x4*)(sDt + hs * 64 + s0);
                    float v[4];
#pragma unroll
                    for (int j = 0; j < 4; ++j) v[j] = (s0 + j <= t) ? g4[j] * __expf(at - a4[j]) * d4[j] : 0.0f;
                    pk.x = pk2(v[0], v[1]); pk.y = pk2(v[2], v[3]); }
                *(LAS u32x2*)(Pm + t * 72 + 16 * ni + 4 * lq) = pk;
            }
            LDS_WAIT();
            const float ea = __expf(at); float ssum = 0.f;
#pragma unroll
            for (int pi = 0; pi < 4; ++pi) { f32x4 ia = zero4(), ie = zero4();
#pragma unroll
                for (int ks = 0; ks < 2; ++ks) ia = MFMA16(ldT(Xh + (32 * ks) * 72 + 16 * pi, 72, lane), ldN(Pm + (32 * rh + 16 * tt) * 72 + 32 * ks, 72, lane), ia);
#pragma unroll
                for (int ks = 0; ks < 4; ++ks) ie = MFMA16(sf[pi][ks], ldN(Cm + (32 * rh + 16 * tt) * 136 + 32 * ks, 136, lane), ie);
                const int p0 = 16 * pi + 4 * lq;
                const u32x2 xw = *(const LAS u32x2*)(Xh + t * 72 + p0);
                const u32x2 zw = *(const u32x2*)(proj + (size_t)(t0 + t) * LDP + PC_SZ + h * 64 + p0);
                const float xv[4] = {bflo(xw.x), bfhi(xw.x), bflo(xw.y), bfhi(xw.y)}, zv[4] = {bflo(zw.x), bfhi(zw.x), bflo(zw.y), bfhi(zw.y)};
#pragma unroll
                for (int j = 0; j < 4; ++j) { const float y = ia[j] + ea * ie[j] + dsk * xv[j]; const float gv = y * zv[j] * sigmoid_f(zv[j]); gat[tt][pi][j] = gv; ssum += gv * gv; }
            }
            ssum += xshfl_f(ssum, lane, 16); ssum += xshfl_f(ssum, lane, 32);
            if (lq == 0) ssq[t * 4 + hs] = ssum;
        }
        __syncthreads();
#pragma unroll
        for (int tt = 0; tt < 2; ++tt) {
            const int t = 32 * rh + 16 * tt + lr;
            const f32x4 q4 = *(const LAS f32x4*)(ssq + t * 4);
            const float r = rsqrtf(((q4.x + q4.y) + (q4.z + q4.w)) * (1.0f / 256.0f) + EPSN);
#pragma unroll
            for (int pi = 0; pi < 4; ++pi) { const int p0 = 16 * pi + 4 * lq;
                const f32x4 w = *(const f32x4*)(X.snorm_w + l * 512 + h * 64 + p0);
                u32x2 o; o.x = pk2(gat[tt][pi][0] * r * w.x, gat[tt][pi][1] * r * w.y); o.y = pk2(gat[tt][pi][2] * r * w.z, gat[tt][pi][3] * r * w.w);
                *(u32x2*)(mix + (size_t)(t0 + t) * DM + 512 + h * 64 + p0) = o; }
        }
        __syncthreads();
    }
}

typedef __bf16 bf16x2_t __attribute__((ext_vector_type(2)));
__device__ __forceinline__ float dot2_bf16(unsigned a, unsigned b, float acc) { return __builtin_amdgcn_fdot2_f32_bf16(__builtin_bit_cast(bf16x2_t, a), __builtin_bit_cast(bf16x2_t, b), acc, false); }
template <int PASS> __device__ __forceinline__ void dsa_attend_head(const Ctx& X, int t_first, int t_stride, int h) {
    constexpr int NQ = 8, NB = 4 * NQ;
    const int lane = opaque_v(X.lane), g = lane >> 3, c = lane & 7;
    const bf16_t* proj = (const bf16_t*)(X.ws + WS_R1);
    const char* pbase = (const char*)proj;
    const unsigned kbase = (unsigned)(PC_AK + h * 64 + 8 * c) * 2u, vbase = (unsigned)(PC_AV + h * 64 + 8 * c) * 2u;
    const LAS unsigned short* selL = (const LAS unsigned short*)(X.lds + X.wave * 12544);
    LAS unsigned short* pH = (LAS unsigned short*)(X.lds + X.wave * 12544 + 4096);
    const LAS int* nL = (const LAS int*)(X.lds + X.wave * 12544 + 12288);
    u32x4 buf[4][8];
#define AH_LOAD(slot, bb, basep) do { const int gg_ = opaque_v(g); const u32x4 s_ = *(const LAS u32x4*)(selL + (bb) * 64 + gg_ * 8); \
        const unsigned sw_[4] = {s_.x, s_.y, s_.z, s_.w}; _Pragma("unroll") for (int u = 0; u < 8; ++u) { \
        const unsigned k_ = (u & 1) ? (sw_[u >> 1] >> 16) : (sw_[u >> 1] & 0xffffu); \
        buf[slot][u] = *(const u32x4*)(pbase + (k_ * (unsigned)(LDP * 2) + (basep))); } __builtin_amdgcn_sched_barrier(0); } while (0)
    if (PASS == 0) {
    AH_LOAD(0, 0, kbase); AH_LOAD(1, 1, kbase); AH_LOAD(2, 2, kbase);
#pragma unroll 1
    for (int j = 0; j < NQ; ++j) {
        const int t_ = t_first + j * t_stride, t = t_ < SEQ ? t_ : SEQ - 1, nj = nL[j];
        const u32x4 qraw = *(const u32x4*)(proj + (size_t)t * LDP + PC_AQ + h * 64 + 8 * c);
        float lgq[4]; float mxl = -INFINITY;
#pragma unroll
        for (int b = 0; b < 4; ++b) {
            const int bb = 4 * j + b;
            AH_LOAD((b + 3) & 3, (bb + 3 < NB ? bb + 3 : NB - 1), kbase);
            float x[8];
#pragma unroll
            for (int u = 0; u < 8; ++u) x[u] = dot2_bf16(buf[b][u].x, qraw.x, dot2_bf16(buf[b][u].y, qraw.y, dot2_bf16(buf[b][u].z, qraw.z, dot2_bf16(buf[b][u].w, qraw.w, 0.0f))));
#define TR_STEP(HALF, CTRL, BIT) _Pragma("unroll") for (int hh = 0; hh < (HALF); ++hh) { const float lo_ = x[hh], hi_ = x[hh + (HALF)]; \
                const float t1_ = lo_ + DPPF(lo_, CTRL), t2_ = hi_ + DPPF(hi_, CTRL); x[hh] = (c & (BIT)) ? t2_ : t1_; }
            TR_STEP(4, 0x141, 4) TR_STEP(2, 0x4E, 2) TR_STEP(1, 0xB1, 1)
#undef TR_STEP
            const float keep = (64 * b + 8 * c + g < nj) ? x[0] * 0.125f : -INFINITY; lgq[b] = keep; mxl = fmaxf(mxl, keep);
            __builtin_amdgcn_sched_barrier(0);
        }
        const float mx = wave_max(mxl);
        float p[4], sm = 0.f;
#pragma unroll
        for (int b = 0; b < 4; ++b) { p[b] = __expf(lgq[b] - mx); sm += p[b]; }
        const float inv = 1.0f / wave_sum(sm);
#pragma unroll
        for (int b = 0; b < 4; ++b) pH[j * 256 + 64 * b + 8 * g + c] = (unsigned short)f2bf(p[b] * inv);
    }
    LDS_WAIT();
    } else {
    AH_LOAD(0, 0, vbase); AH_LOAD(1, 1, vbase); AH_LOAD(2, 2, vbase);
#pragma unroll 1
    for (int j = 0; j < NQ; ++j) {
        const int t_ = t_first + j * t_stride, t = t_ < SEQ ? t_ : SEQ - 1;
        float a[8];
#pragma unroll
        for (int d = 0; d < 8; ++d) a[d] = 0.f;
#pragma unroll
        for (int b = 0; b < 4; ++b) {
            const int bb = 4 * j + b;
            AH_LOAD((b + 3) & 3, (bb + 3 < NB ? bb + 3 : NB - 1), vbase);
            const u32x4 p_ = *(const LAS u32x4*)(pH + j * 256 + 64 * b + 8 * g);
            const unsigned pw[4] = {p_.x, p_.y, p_.z, p_.w};
#pragma unroll
            for (int k = 0; k < 4; ++k) {
                const u32x4 e0 = buf[b][2 * k], e1 = buf[b][2 * k + 1];
                a[0] = dot2_bf16(__builtin_amdgcn_perm(e1.x, e0.x, 0x05040100u), pw[k], a[0]); a[1] = dot2_bf16(__builtin_amdgcn_perm(e1.x, e0.x, 0x07060302u), pw[k], a[1]);
                a[2] = dot2_bf16(__builtin_amdgcn_perm(e1.y, e0.y, 0x05040100u), pw[k], a[2]); a[3] = dot2_bf16(__builtin_amdgcn_perm(e1.y, e0.y, 0x07060302u), pw[k], a[3]);
                a[4] = dot2_bf16(__builtin_amdgcn_perm(e1.z, e0.z, 0x05040100u), pw[k], a[4]); a[5] = dot2_bf16(__builtin_amdgcn_perm(e1.z, e0.z, 0x07060302u), pw[k], a[5]);
                a[6] = dot2_bf16(__builtin_amdgcn_perm(e1.w, e0.w, 0x05040100u), pw[k], a[6]); a[7] = dot2_bf16(__builtin_amdgcn_perm(e1.w, e0.w, 0x07060302u), pw[k], a[7]);
                __builtin_amdgcn_sched_barrier(0); }
        }
#pragma unroll
        for (int d = 0; d < 8; ++d) { a[d] += xshfl_f(a[d], lane, 8); a[d] += xshfl_f(a[d], lane, 16); a[d] += xshfl_f(a[d], lane, 32); }
        if (g == 0) { u32x4 o; o.x = pk2(a[0], a[1]); o.y = pk2(a[2], a[3]); o.z = pk2(a[4], a[5]); o.w = pk2(a[6], a[7]);
            *(u32x4*)((bf16_t*)(X.ws + WS_MIX) + (size_t)t * DM + 256 + h * 64 + 8 * c) = o; }
    }
    }
#undef AH_LOAD
    LDS_WAIT();
}
__device__ __forceinline__ void dsa_attend_load_sel(const Ctx& X, int t_first, int t_stride) {
    const int lane = X.lane;
    LAS unsigned short* selL = (LAS unsigned short*)(X.lds + X.wave * 12544);
    LAS int* nL = (LAS int*)(X.lds + X.wave * 12544 + 12288);
#pragma unroll 1
    for (int j = 0; j < 8; ++j) {
        const int t_ = t_first + j * t_stride, t = t_ < SEQ ? t_ : SEQ - 1;
        const unsigned short* srow = (const unsigned short*)(X.ws + WS_SEL) + (size_t)t * 256;
        const int n = ((const int*)(X.ws + WS_SMALL))[SM_SELCNT + t];
#pragma unroll
        for (int k = 0; k < 4; ++k) { const int i = lane + 64 * k;
            selL[j * 256 + (i & ~63) + (i & 7) * 8 + ((i >> 3) & 7)] = (i < n) ? srow[i] : (unsigned short)0; }
        if (lane == 0) nL[j] = n;
    }
    LDS_WAIT();
}

__device__ __forceinline__ void xcd_seam(const Ctx& X) {
    XcdBarrier b_; b_.bar = (unsigned*)(X.ws + WS_CTL) + 1024; b_.x = xb_xcc_id(); b_.st = (volatile LAS unsigned*)(X.lds + LDS_BYTES - 64);
    xcd_local_sync(b_, X.wave == 0 && X.lane == 0);
}
__device__ __forceinline__ void grid_seam(const Ctx& X) {
    XcdBarrier b_; b_.bar = (unsigned*)(X.ws + WS_CTL) + 1024; b_.x = xb_xcc_id(); b_.st = (volatile LAS unsigned*)(X.lds + LDS_BYTES - 64);
    xcd_barrier(b_, X.wave == 0 && X.lane == 0);
}
#ifndef PH_MASK
#define PH_MASK 0x3FF
#endif
#define PH_ON(k) ((PH_MASK >> (k)) & 1)
__device__ __forceinline__ void run_phase(const Ctx& X, int ph) {
    if (ph == 0) { if (PH_ON(9)) p0_prologue(X); return; }
    const int l = (ph - 1) / 9, k = (ph - 1) % 9;
    const bf16_t* H = (const bf16_t*)(X.ws + WS_H);
    switch (k) {
    case 0: if (PH_ON(0)) {
        pg8::Gemm g{H, (const bf16_t*)(X.ws + WS_WIN), SEQ, NPROJ, 1024}; pg8::StaticOrder S; S.init(SEQ, NPROJ, X.G, X.bid);
        pg8::EpiProj E{(bf16_t*)(X.ws + WS_R1), LDP, (float*)(X.ws + WS_GATES), (const float*)(X.ws + WS_CS), (bf16_t*)(X.ws + WS_IKC)};
        pg8::gemm_phase<pg8::EpiProj, pg8::StaticOrder, true, true>(X.lds, g, S, E, X.wave);
        {
            const int nwg = (SEQ / 256) * (NPROJ / 256), rounds = (nwg + X.G - 1) / X.G, nfull = nwg - (rounds - 1) * X.G;
            if (nfull < X.G && X.bid >= nfull) { asm volatile("s_waitcnt vmcnt(0)" ::: "memory"); __syncthreads(); convert_layer(X, l, CV_OUT, CV_GU, X.bid - nfull, X.G - nfull); }
            else if (nfull >= X.G) { asm volatile("s_waitcnt vmcnt(0)" ::: "memory"); __syncthreads(); convert_layer(X, l, CV_OUT, CV_GU, X.bid, X.G); }
        }
    } break;
    case 1: if (PH_ON(1)) {
#ifndef PROBE_SUB
#define PROBE_SUB 0
#endif
#ifndef B1_NOCHUNK
        for (int r_ = 0; r_ < (PROBE_SUB == 1 ? 2 : 1); ++r_)
        for (int c = X.bid; c < 256; c += X.G) b1_chunk(X, l, c);
#endif
#ifndef B1_NODSA
#if PROBE_SUB == 2
        for (int i = X.bid; i < 512; i += X.G) { dsa_index_item(X, i); dsa_index_item(X, 1023 - i); }
#endif
        {
            int* ctr = (int*)(X.ws + WS_CTL + 32768) + l * 64;
            LAS int* nxt_ = (LAS int*)(X.lds + IDX_CTL + 14848);
            const bool t0_ = opaque_v(X.tid) == 0;
            int pre_ = 0;
            if (t0_) pre_ = __hip_atomic_fetch_add(ctr, 1, __ATOMIC_RELAXED, __HIP_MEMORY_SCOPE_AGENT);
            for (;;) {
                if (t0_) *nxt_ = pre_;
                __syncthreads();
                const int it_ = __builtin_amdgcn_readfirstlane(*nxt_);
                if (it_ >= 1024) break;
                if (t0_) pre_ = __hip_atomic_fetch_add(ctr, 1, __ATOMIC_RELAXED, __HIP_MEMORY_SCOPE_AGENT);
                dsa_index_item(X, 1023 - it_);
            }
        }
#endif
    } break;
    case 2: if (PH_ON(2)) b2_scan(X); break;
    case 3: if (PH_ON(3)) {
#ifndef B3_NOCHUNK
        for (int r_ = 0; r_ < (PROBE_SUB == 3 ? 2 : 1); ++r_)
        for (int c = X.bid; c < 256; c += X.G) b3_chunk(X, l, c);
#endif
#ifndef B3_NOATT
        for (int r_ = 0; r_ < (PROBE_SUB == 4 ? 2 : 1); ++r_)
        {
            const int gw = X.bid * NWAVES + X.wave, NGW = X.G * NWAVES;
            dsa_attend_load_sel(X, gw, NGW);
            for (int h = 0; h < 4; ++h) { dsa_attend_head<0>(X, gw, NGW, h); xcd_seam(X); dsa_attend_head<1>(X, gw, NGW, h); if (h < 3) xcd_seam(X); }
        }
#endif
    } break;
    case 4: if (PH_ON(4)) {
        pg8::Gemm g{(const bf16_t*)(X.ws + WS_MIX), (const bf16_t*)(X.ws + WS_WOUT), SEQ, 1024, 1024}; pg8::StaticOrder S; S.init(SEQ, 1024, X.G, X.bid);
        pg8::EpiBf16 E{(bf16_t*)(X.ws + WS_R1), 1024};
        pg8::gemm_phase<pg8::EpiBf16, pg8::StaticOrder, true, true>(X.lds, g, S, E, X.wave);
    } break;
    case 5: if (PH_ON(5)) {
        if (l == 0) norm_phase<true, false>(X, (const bf16_t*)(X.ws + WS_R1), X.x_in, X.norm_w + (size_t)(l * 4 + 1) * DM, X.norm_w + (size_t)(l * 4 + 2) * DM);
        else        norm_phase<false, false>(X, (const bf16_t*)(X.ws + WS_R1), X.out, X.norm_w + (size_t)(l * 4 + 1) * DM, X.norm_w + (size_t)(l * 4 + 2) * DM);
    } break;
    case 6: if (PH_ON(6)) {
        pg8::Gemm g{H, (const bf16_t*)(X.ws + WS_WGU), SEQ, 2 * DFF, 1024}; pg8::StaticOrder S; S.init(SEQ, 2 * DFF, X.G, X.bid);
        pg8::EpiSwiGLU E{(bf16_t*)(X.ws + WS_R1), DFF};
        pg8::gemm_phase<pg8::EpiSwiGLU, pg8::StaticOrder, true, true>(X.lds, g, S, E, X.wave);
        if (l + 1 < NLAYER) {
            const int nwg = (SEQ / 256) * (2 * DFF / 256), rounds = (nwg + X.G - 1) / X.G, nfull = nwg - (rounds - 1) * X.G;
            if (nfull < X.G && X.bid >= nfull) { asm volatile("s_waitcnt vmcnt(0)" ::: "memory"); __syncthreads(); convert_layer(X, l + 1, 0, CV_OUT, X.bid - nfull, X.G - nfull); }
            else if (nfull >= X.G) { asm volatile("s_waitcnt vmcnt(0)" ::: "memory"); __syncthreads(); convert_layer(X, l + 1, 0, CV_OUT, X.bid, X.G); }
        }
    } break;
    case 7: if (PH_ON(7)) {
        pg8::Gemm g{(const bf16_t*)(X.ws + WS_R1), (const bf16_t*)(X.ws + WS_WDN), SEQ, 1024, DFF}; pg8::StaticOrder S; S.init(SEQ, 1024, X.G, X.bid);
        pg8::EpiBf16 E{(bf16_t*)(X.ws + WS_R2), 1024};
        pg8::gemm_phase<pg8::EpiBf16, pg8::StaticOrder, true, true>(X.lds, g, S, E, X.wave);
    } break;
    default: if (PH_ON(8)) {
        if (l + 1 < NLAYER) norm_phase<false, false>(X, (const bf16_t*)(X.ws + WS_R2), X.out, X.norm_w + (size_t)(l * 4 + 3) * DM, X.norm_w + (size_t)((l + 1) * 4) * DM);
        else                norm_phase<false, true>(X, (const bf16_t*)(X.ws + WS_R2), X.out, X.norm_w + (size_t)(l * 4 + 3) * DM, nullptr);
        if (l + 1 < NLAYER) convert_layer(X, l + 1, CV_GU, CV_ALL, X.bid, X.G);
    } break;
    }
}

struct Args { const void* in[16]; float* out; unsigned char* ws; int ph_lo, ph_hi; };
__global__ void __launch_bounds__(NTHR, 2) hyb_fwd(Args a) {
    extern __shared__ __attribute__((aligned(16))) unsigned char lds_raw[];
    Ctx X;
    X.lds = (LAS unsigned char*)lds_raw; X.G = gridDim.x; X.bid = blockIdx.x; X.wave = __builtin_amdgcn_readfirstlane((int)threadIdx.x >> 6);
    const int ph_lo = a.ph_lo, ph_hi = a.ph_hi;
#if !MK_MULTI
    volatile LAS unsigned* bst = (volatile LAS unsigned*)((LAS unsigned char*)lds_raw + LDS_BYTES - 64);
    if (threadIdx.x < 2) bst[threadIdx.x] = 0u;
    __syncthreads();
    (void)xcd_barrier_post((unsigned*)(a.ws + WS_CTL) + 1024, bst, threadIdx.x == 0);
#define GRID_SEAM(first) do { if (ph_lo < 0) cg::this_grid().sync();     \
        { XcdBarrier b_; b_.bar = (unsigned*)(X.ws + WS_CTL) + 1024; b_.x = xb_xcc_id(); \
        b_.st = (volatile LAS unsigned*)((LAS unsigned char*)lds_raw + LDS_BYTES - 64); xcd_barrier(b_, X.wave == 0 && X.lane == 0); } } while (0)
#else
#define GRID_SEAM(first) do { } while (0)
#endif
#pragma unroll 1
    for (int ph = ph_lo; ph < ph_hi; ++ph) {
        { int l_; asm volatile("v_mbcnt_lo_u32_b32 %0, -1, 0\n\tv_mbcnt_hi_u32_b32 %0, -1, %0" : "=v"(l_)); X.lane = l_; X.tid = l_ + 64 * X.wave; }
        {
            const __attribute__((address_space(4))) Args* k = (const __attribute__((address_space(4))) Args*)__builtin_amdgcn_kernarg_segment_ptr();
            asm volatile("" : "+s"(k));
            X.x_in = (const float*)k->in[0]; X.pos = (const int*)k->in[1]; X.norm_w = (const float*)k->in[2]; X.w_in = (const float*)k->in[3]; X.gate_b = (const float*)k->in[4];
            X.mnorm_w = (const float*)k->in[5]; X.conv_w = (const float*)k->in[6]; X.conv_b = (const float*)k->in[7]; X.dt_bias = (const float*)k->in[8]; X.a_log = (const float*)k->in[9];
            X.d_skip = (const float*)k->in[10]; X.snorm_w = (const float*)k->in[11]; X.w_out = (const float*)k->in[12]; X.w_gate = (const float*)k->in[13]; X.w_up = (const float*)k->in[14]; X.w_down = (const float*)k->in[15];
            X.out = k->out; X.ws = k->ws;
        }
#if defined(PROBE_KIND)
        {
            const int reps_ = (ph > 0 && ((ph - 1) % 9) == PROBE_KIND) ? PROBE_REPS : 1;
            for (int r_ = 1; r_ < reps_; ++r_) { run_phase(X, ph); GRID_SEAM(false); }
        }
#endif
        run_phase(X, ph);
        if (ph + 1 < ph_hi) GRID_SEAM(ph == ph_lo);
    }
}

extern "C" void kernel_launch(void* const* d_in, const int* in_sizes, int n_in, void* d_out, int out_size, void* d_ws, size_t ws_size, hipStream_t stream) {
    static int grid = 0;
    if (grid == 0) {
        if (n_in != 16 || out_size != SEQ * DM || ws_size < WS_END) { fprintf(stderr, "kernel_launch: unexpected shapes (n_in %d out %d ws %zu)\n", n_in, out_size, ws_size); grid = -1; return; }
        int dev = 0, cus = 0, per_cu = 0;
        if (hipGetDevice(&dev) != hipSuccess || hipDeviceGetAttribute(&cus, hipDeviceAttributeMultiprocessorCount, dev) != hipSuccess) { grid = -1; return; }
        if (hipFuncSetAttribute((const void*)hyb_fwd, hipFuncAttributeMaxDynamicSharedMemorySize, LDS_BYTES) != hipSuccess) { fprintf(stderr, "kernel_launch: hipFuncSetAttribute failed\n"); grid = -1; return; }
        if (hipOccupancyMaxActiveBlocksPerMultiprocessor(&per_cu, (const void*)hyb_fwd, NTHR, LDS_BYTES) != hipSuccess || per_cu < 1) { fprintf(stderr, "kernel_launch: occupancy query says %d\n", per_cu); per_cu = 1; }
        (void)hipGetLastError();
        grid = cus * 1;
        if (grid > 256) grid = 256;
    }
    if (grid < 0) return;
    if (hipMemsetAsync((char*)d_ws + WS_CTL, 0, 65536, stream) != hipSuccess) { fprintf(stderr, "kernel_launch: memset of the control words failed\n"); return; }
    Args a{};
    for (int i = 0; i < 16; ++i) a.in[i] = d_in[i];
    a.out = (float*)d_out; a.ws = (unsigned char*)d_ws;
#if MK_MULTI
    for (int ph = 0; ph < NPH; ++ph) { a.ph_lo = ph; a.ph_hi = ph + 1; hipLaunchKernelGGL(hyb_fwd, dim3(grid), dim3(NTHR), LDS_BYTES, stream, a); }
#else
    a.ph_lo = 0; a.ph_hi = NPH;
    void* args[] = {&a};
    hipError_t e = hipLaunchCooperativeKernel((const void*)hyb_fwd, dim3(grid), dim3(NTHR), args, LDS_BYTES, stream);
    if (e != hipSuccess) fprintf(stderr, "kernel_launch: cooperative launch failed: %s (grid %d)\n", hipGetErrorString(e), grid);
#endif
}
```

```cpp
#include <hip/hip_runtime.h>
#include <hip/hip_cooperative_groups.h>
#include <cstdio>
#include <cstdint>
namespace cg = cooperative_groups;

#ifndef MK_MULTI
#define MK_MULTI 0
#endif

namespace pg8 {
#define PG8_LAS __attribute__((address_space(3)))
typedef unsigned short bf16_t;
typedef short bf16x8 __attribute__((ext_vector_type(8)));
typedef float f32x4 __attribute__((ext_vector_type(4)));
typedef unsigned u32x4 __attribute__((ext_vector_type(4)));
constexpr int BM = 256, BK = 64, HALF = 128, HTB = HALF * BK * 2  , STAGE_BYTES = 8 * HTB, NXCD = 8, WGM = 8;

__host__ __device__ __forceinline__ int lds_byte(int r, int c) { const int st = (r >> 4) * 2 + (c >> 5), rr = r & 15, cc = c & 31, ob = rr * 64 + cc * 2; return st * 1024 + (ob ^ (((ob >> 9) & 1) << 5)); }
__host__ __device__ __forceinline__ void stage_rc(int b, int& R, int& C) { const int st = b / 1024, sb = b % 1024, swz = sb ^ (((sb >> 9) & 1) << 5); R = (st >> 1) * 16 + swz / 64; C = (st & 1) * 32 + (swz % 64) / 2; }
__host__ __device__ __forceinline__ int perm32(int rho) { const int n = rho >> 4, i = rho & 15; return 8 * (i >> 2) + 4 * n + (i & 3); }

struct Unit { int pm, pn; };
struct Gemm { const bf16_t* A; const bf16_t* Bt; int M, N, K; };

struct StaticOrder {
    int nM, nN, nwg, G, c;
    __host__ __device__ void init(int M, int N, int G_, int c_) { nM = M / BM; nN = N / BM; nwg = nM * nN; G = G_; c = c_; }
    __host__ __device__ bool next(int i, Unit& u) const {
        const long L = (long)i * G + c; if (L >= nwg) return false;
        int wgid = (int)L; { const int q = nwg / NXCD, r = nwg % NXCD, xcd = wgid % NXCD, off = wgid / NXCD; wgid = (xcd < r ? xcd * (q + 1) : r * (q + 1) + (xcd - r) * q) + off; }
        const int nig = WGM * nN, gid = wgid / nig, fm = gid * WGM, gsz = (nM - fm) < WGM ? (nM - fm) : WGM;
        u.pm = fm + ((wgid % nig) % gsz); u.pn = (wgid % nig) / gsz; return true;
    }
    __device__ __forceinline__ void a_ready(const Unit&) const {}
    __device__ __forceinline__ void done(const Unit&) const {}
};


__device__ __forceinline__ unsigned cvt_pk_bf16(float lo, float hi) { unsigned r; asm volatile("v_cvt_pk_bf16_f32 %0, %1, %2" : "=v"(r) : "v"(lo), "v"(hi)); return r; }

__device__ __forceinline__ void st16_wt(void* p, u32x4 v) { asm volatile("global_store_dwordx4 %0, %1, off sc0 sc1\n\ts_nop 1" :: "v"(p), "v"(v) : "memory"); }

struct EpiBf16 {
    static constexpr bool PERM = true, AFTER_DRAIN = false;
    bf16_t* O; int ldc;
    __device__ __forceinline__ void operator()(const f32x4 (&acc)[2][2][4][2], const Unit& u, int wr, int wc, int fr, int fq) const {
        const int row0 = u.pm * BM + wr * 64 + fr, col0 = u.pn * BM + wc * 32 + 8 * fq;
#pragma unroll
        for (int ai = 0; ai < 2; ++ai)
#pragma unroll
            for (int m = 0; m < 4; ++m) { bf16_t* rowp = O + (size_t)(row0 + ai * HALF + m * 16) * ldc + col0;
#pragma unroll
                for (int bj = 0; bj < 2; ++bj) { const f32x4 v0 = acc[ai][bj][m][0], v1 = acc[ai][bj][m][1];
                    u32x4 w; w.x = cvt_pk_bf16(v0[0], v0[1]); w.y = cvt_pk_bf16(v0[2], v0[3]); w.z = cvt_pk_bf16(v1[0], v1[1]); w.w = cvt_pk_bf16(v1[2], v1[3]);
                    *(u32x4*)(rowp + bj * HALF) = w; } }
    }
};

struct EpiF32 {
    static constexpr bool PERM = false, AFTER_DRAIN = false;
    float* O; int ldc;
    __device__ __forceinline__ void operator()(const f32x4 (&acc)[2][2][4][2], const Unit& u, int wr, int wc, int fr, int fq) const {
        const int row0 = u.pm * BM + wr * 64 + fr, col0 = u.pn * BM + wc * 32 + 4 * fq;
#pragma unroll
        for (int ai = 0; ai < 2; ++ai)
#pragma unroll
            for (int m = 0; m < 4; ++m) { float* rowp = O + (size_t)(row0 + ai * HALF + m * 16) * ldc + col0;
#pragma unroll
                for (int bj = 0; bj < 2; ++bj)
#pragma unroll
                    for (int n = 0; n < 2; ++n) *(f32x4*)(rowp + bj * HALF + n * 16) = acc[ai][bj][m][n]; }
    }
};

__device__ __forceinline__ float silu_f(float g) { return g * __builtin_amdgcn_rcpf(1.0f + __expf(-g)); }
typedef float f32x2 __attribute__((ext_vector_type(2)));
__device__ __forceinline__ unsigned swiglu_pk2(float g0, float g1, float u0, float u1) {
    const f32x2 g = (f32x2){g0, g1}, u = (f32x2){u0, u1};
    const f32x2 a = g * (f32x2){-1.4426950408889634f, -1.4426950408889634f};
    f32x2 e; e.x = __builtin_amdgcn_exp2f(a.x); e.y = __builtin_amdgcn_exp2f(a.y);
    const f32x2 d = e + (f32x2){1.0f, 1.0f};
    f32x2 r; r.x = __builtin_amdgcn_rcpf(d.x); r.y = __builtin_amdgcn_rcpf(d.y);
    const f32x2 o = (g * u) * r;
    return cvt_pk_bf16(o.x, o.y);
}

struct EpiSwiGLU {
    static constexpr bool PERM = true, AFTER_DRAIN = false;
    bf16_t* O; int ldc;
    __device__ __forceinline__ void operator()(const f32x4 (&acc)[2][2][4][2], const Unit& u, int wr, int wc, int fr, int fq) const {
        const int row0 = u.pm * BM + wr * 64 + fr, col0 = u.pn * HALF + wc * 32 + 8 * fq;
#pragma unroll
        for (int ai = 0; ai < 2; ++ai)
#pragma unroll
            for (int m = 0; m < 4; ++m) {
                const f32x4 g0 = acc[ai][0][m][0], g1 = acc[ai][0][m][1], u0 = acc[ai][1][m][0], u1 = acc[ai][1][m][1];
                u32x4 w;
                w.x = swiglu_pk2(g0[0], g0[1], u0[0], u0[1]); w.y = swiglu_pk2(g0[2], g0[3], u0[2], u0[3]);
                w.z = swiglu_pk2(g1[0], g1[1], u1[0], u1[1]); w.w = swiglu_pk2(g1[2], g1[3], u1[2], u1[3]);
                st16_wt(O + (size_t)(row0 + ai * HALF + m * 16) * ldc + col0, w); }
    }
};

struct EpiProj {
    static constexpr bool PERM = true, AFTER_DRAIN = false;
    bf16_t* P; int ldc; float* gates; const float* cs; bf16_t* ikc;
    __device__ __forceinline__ void operator()(f32x4 (&acc)[2][2][4][2], const Unit& u, int wr, int wc, int fr, int fq) const {
        const int row0 = u.pm * BM + wr * 64 + fr, pn = u.pn;
        const bool ropeT = (pn == 4 || pn == 5 || pn == 7);
        const bool rope0 = ((wc & 1) == 0) && (ropeT || (pn == 14 && wc == 0)), rope1 = ((wc & 1) == 0) && ropeT;
        if (rope0) {
            const float sg = (fq == 0) ? -1.0f : 1.0f;
            f32x4 nx[4];
            { const float* cp = cs + (size_t)row0 * 16; nx[0] = *(const f32x4*)cp; nx[1] = *(const f32x4*)(cp + 4); nx[2] = *(const f32x4*)(cp + 8); nx[3] = *(const f32x4*)(cp + 12); }
#pragma unroll
            for (int idx = 0; idx < 8; ++idx) {
                const int ai = idx >> 2, m = idx & 3;
                const f32x4 c0 = nx[0], c1 = nx[1], s0 = nx[2], s1 = nx[3];
                if (idx + 1 < 8) { const int rn = row0 + ((idx + 1) >> 2) * HALF + ((idx + 1) & 3) * 16; const float* cp = cs + (size_t)rn * 16;
                    nx[0] = *(const f32x4*)cp; nx[1] = *(const f32x4*)(cp + 4); nx[2] = *(const f32x4*)(cp + 8); nx[3] = *(const f32x4*)(cp + 12); }
#pragma unroll
                for (int bj = 0; bj < 2; ++bj) {
                    if (bj == 1 && !rope1) continue;
                    f32x4 v0 = acc[ai][bj][m][0], v1 = acc[ai][bj][m][1], p0, p1;
#pragma unroll
                    for (int i = 0; i < 4; ++i) { p0[i] = __shfl_xor(v0[i], 16); p1[i] = __shfl_xor(v1[i], 16); }
                    if (fq < 2) { acc[ai][bj][m][0] = v0 * c0 + sg * (p0 * s0); acc[ai][bj][m][1] = v1 * c1 + sg * (p1 * s1); }
                }
            }
        }
#pragma unroll
        for (int ai = 0; ai < 2; ++ai)
#pragma unroll
            for (int m = 0; m < 4; ++m) {
                const int row = row0 + ai * HALF + m * 16;
#pragma unroll
                for (int bj = 0; bj < 2; ++bj) {
                    const f32x4 v0 = acc[ai][bj][m][0], v1 = acc[ai][bj][m][1];
                    u32x4 w; w.x = cvt_pk_bf16(v0[0], v0[1]); w.y = cvt_pk_bf16(v0[2], v0[3]); w.z = cvt_pk_bf16(v1[0], v1[1]); w.w = cvt_pk_bf16(v1[2], v1[3]);
                    st16_wt(P + (size_t)row * ldc + pn * BM + bj * HALF + wc * 32 + 8 * fq, w);
                    if (pn == 14 && bj == 0 && wc < 2) st16_wt(ikc + ((size_t)(((row >> 4) * 2 + wc) * 4 + fq) * 16 + (row & 15)) * 8, w);
                    if (pn == 14 && bj == 0 && wc == 2) { st16_wt(gates + (size_t)row * 32 + 8 * fq, __builtin_bit_cast(u32x4, v0)); st16_wt(gates + (size_t)row * 32 + 8 * fq + 4, __builtin_bit_cast(u32x4, v1)); }
                }
            }
    }
};

struct PanelSS {
    float* xbuf;
    unsigned* cnt;
    int M; float eps, inv_n;
    __device__ __forceinline__ void run(const f32x4 (&v)[2][2][4][2], const Unit& u, const int use, int wr, int wc, int fr, int fq, PG8_LAS unsigned char* lds, int wid, int lane) const {
        run_a(v, u, use, wr, wc, fr, fq, lds, wid, lane); run_b(u, use, lds, wid, lane); }
    __device__ __forceinline__ void run_a(const f32x4 (&v)[2][2][4][2], const Unit& u, const int use, int wr, int wc, int fr, int fq, PG8_LAS unsigned char* lds, int wid, int lane) const {
        PG8_LAS float* P = (PG8_LAS float*)lds;
#pragma unroll
        for (int ai = 0; ai < 2; ++ai)
#pragma unroll
            for (int m = 0; m < 4; ++m) {
                float s = 0.f;
#pragma unroll
                for (int bj = 0; bj < 2; ++bj)
#pragma unroll
                    for (int n = 0; n < 2; ++n) { const f32x4 x = v[ai][bj][m][n]; s += (x[0] * x[0] + x[1] * x[1]) + (x[2] * x[2] + x[3] * x[3]); }
                s += __shfl_xor(s, 16); s += __shfl_xor(s, 32);
                if (fq == 0) P[(ai * HALF + wr * 64 + m * 16 + fr) * 4 + wc] = s;
            }
        asm volatile("s_waitcnt lgkmcnt(0)" ::: "memory"); __builtin_amdgcn_s_barrier(); asm volatile("" ::: "memory");
        const int row = wid * 32 + (lane & 31);
        float* slots = xbuf + (size_t)(use & 1) * M * 4;
        if (lane < 32) { const f32x4 p = *(const PG8_LAS f32x4*)(P + row * 4);
            __hip_atomic_store(slots + (size_t)(u.pm * BM + row) * 4 + u.pn, (p[0] + p[1]) + (p[2] + p[3]), __ATOMIC_RELAXED, __HIP_MEMORY_SCOPE_AGENT); }
        asm volatile("s_waitcnt vmcnt(0)" ::: "memory");
        if (lane == 0) __hip_atomic_fetch_add(cnt + 32 * u.pm, 1u, __ATOMIC_RELAXED, __HIP_MEMORY_SCOPE_AGENT);
    }
    __device__ __forceinline__ void run_b(const Unit& u, const int use, PG8_LAS unsigned char* lds, int wid, int lane) const {
        PG8_LAS float* S = (PG8_LAS float*)(lds + 4096);
        const int row = wid * 32 + (lane & 31);
        float* slots = xbuf + (size_t)(use & 1) * M * 4;
        if (wid == 0) {
            const unsigned want = 32u * (unsigned)(use + 1);
            while ((unsigned)__builtin_amdgcn_readfirstlane((int)__hip_atomic_load(cnt + 32 * u.pm, __ATOMIC_RELAXED, __HIP_MEMORY_SCOPE_AGENT)) < want) __builtin_amdgcn_s_sleep(1);
        }
        asm volatile("s_waitcnt vmcnt(0) lgkmcnt(0)" ::: "memory"); __builtin_amdgcn_s_barrier(); asm volatile("" ::: "memory");
        if (lane < 32) { const float* sl = slots + (size_t)(u.pm * BM + row) * 4; float t = 0.f;
#pragma unroll
            for (int k = 0; k < 4; ++k) t += __hip_atomic_load(sl + k, __ATOMIC_RELAXED, __HIP_MEMORY_SCOPE_AGENT);
            S[row] = rsqrtf(t * inv_n + eps); }
        asm volatile("s_waitcnt lgkmcnt(0)" ::: "memory"); __builtin_amdgcn_s_barrier(); asm volatile("" ::: "memory");
    }
};
template <bool OUT_F32>
struct EpiRmsRes {
    static constexpr bool PERM = true, AFTER_DRAIN = true;
    const bf16_t* xin; int xin_ld; void* xout; int xout_ld; bf16_t* H; const float* wa; const float* wb; PanelSS st; int use0;
    static __device__ __forceinline__ unsigned opq(unsigned x) { asm volatile("" : "+v"(x)); return x; }
    __device__ __forceinline__ void fused(f32x4 (&acc)[2][2][4][2], const Unit& u, int wr, int wc, int fr, int fq, PG8_LAS unsigned char* lds, int wid, int lane) const {
        const PG8_LAS float* S = (const PG8_LAS float*)(lds + 4096);
        const unsigned col0 = (unsigned)(u.pn * BM + wc * 32 + 8 * fq), r0 = (unsigned)(wr * 64 + fr), rowg = (unsigned)(u.pm * BM) + r0;
        const char* xin_b = (const char*)xin; char* xout_b = (char*)xout; char* H_b = (char*)H;
        u32x4 xa[4][2], xb[4][2];
        { const unsigned rg = opq(rowg), ldb = (unsigned)xin_ld * 2u;
#pragma unroll
          for (int m = 0; m < 4; ++m)
#pragma unroll
            for (int bj = 0; bj < 2; ++bj) xa[m][bj] = *(const u32x4*)(xin_b + ((rg + 16u * m) * ldb + (col0 + 128u * bj) * 2u)); }
        { const unsigned rg = opq(rowg) + 128u, ldb = (unsigned)xin_ld * 2u;
#pragma unroll
          for (int m = 0; m < 4; ++m)
#pragma unroll
            for (int bj = 0; bj < 2; ++bj) xb[m][bj] = *(const u32x4*)(xin_b + ((rg + 16u * m) * ldb + (col0 + 128u * bj) * 2u)); }
        f32x4 w[2][2];
#pragma unroll
        for (int bj = 0; bj < 2; ++bj) { w[bj][0] = *(const f32x4*)(wa + col0 + bj * HALF); w[bj][1] = *(const f32x4*)(wa + col0 + bj * HALF + 4); }
        st.run(acc, u, use0, wr, wc, fr, fq, lds, wid, lane);
        asm volatile("" ::: "memory");
        {
#pragma unroll
            for (int ai = 0; ai < 2; ++ai)
#pragma unroll
                for (int m = 0; m < 4; ++m) { const float s = S[ai * HALF + m * 16 + r0];
#pragma unroll
                    for (int bj = 0; bj < 2; ++bj) { const u32x4 x = ai ? xb[m][bj] : xa[m][bj];
                        const f32x4 x0 = (f32x4){__uint_as_float(x.x << 16), __uint_as_float(x.x & 0xffff0000u), __uint_as_float(x.y << 16), __uint_as_float(x.y & 0xffff0000u)};
                        const f32x4 x1 = (f32x4){__uint_as_float(x.z << 16), __uint_as_float(x.z & 0xffff0000u), __uint_as_float(x.w << 16), __uint_as_float(x.w & 0xffff0000u)};
                        acc[ai][bj][m][0] = x0 + acc[ai][bj][m][0] * s * w[bj][0]; acc[ai][bj][m][1] = x1 + acc[ai][bj][m][1] * s * w[bj][1]; }
                    asm volatile("" : "+v"(acc[ai][0][m][0]), "+v"(acc[ai][0][m][1]), "+v"(acc[ai][1][m][0]), "+v"(acc[ai][1][m][1])); }
        }
        if (OUT_F32) {
            const unsigned rg = opq(rowg), ldb = (unsigned)xout_ld * 4u;
#pragma unroll
            for (int ai = 0; ai < 2; ++ai)
#pragma unroll
                for (int m = 0; m < 4; ++m)
#pragma unroll
                    for (int bj = 0; bj < 2; ++bj) { float* o = (float*)(xout_b + ((rg + 128u * ai + 16u * m) * ldb + (col0 + 128u * bj) * 4u));
                        *(f32x4*)o = acc[ai][bj][m][0]; *(f32x4*)(o + 4) = acc[ai][bj][m][1]; }
            return;
        }
        f32x4 w2[2][2];
#pragma unroll
        for (int bj = 0; bj < 2; ++bj) { w2[bj][0] = *(const f32x4*)(wb + col0 + bj * HALF); w2[bj][1] = *(const f32x4*)(wb + col0 + bj * HALF + 4); }
        st.run_a(acc, u, use0 + 1, wr, wc, fr, fq, lds, wid, lane);
        {
            const unsigned rg = opq(rowg), ldb = (unsigned)xout_ld * 2u;
#pragma unroll
            for (int ai = 0; ai < 2; ++ai)
#pragma unroll
                for (int m = 0; m < 4; ++m) { const unsigned row = rg + 128u * ai + 16u * m;
#pragma unroll
                    for (int bj = 0; bj < 2; ++bj) { const f32x4 v0 = acc[ai][bj][m][0], v1 = acc[ai][bj][m][1];
                        u32x4 q; q.x = cvt_pk_bf16(v0[0], v0[1]); q.y = cvt_pk_bf16(v0[2], v0[3]); q.z = cvt_pk_bf16(v1[0], v1[1]); q.w = cvt_pk_bf16(v1[2], v1[3]);
                        *(u32x4*)(xout_b + (row * ldb + (col0 + 128u * bj) * 2u)) = q; } }
        }
        st.run_b(u, use0 + 1, lds, wid, lane);
        {
            const unsigned rg = opq(rowg), ldb = (unsigned)xout_ld * 2u;
#pragma unroll
            for (int ai = 0; ai < 2; ++ai)
#pragma unroll
                for (int m = 0; m < 4; ++m) { const float s = S[ai * HALF + m * 16 + r0]; const unsigned row = rg + 128u * ai + 16u * m;
#pragma unroll
                    for (int bj = 0; bj < 2; ++bj) { const f32x4 v0 = acc[ai][bj][m][0], v1 = acc[ai][bj][m][1];
                        const f32x4 h0 = v0 * s * w2[bj][0], h1 = v1 * s * w2[bj][1];
                        u32x4 g; g.x = cvt_pk_bf16(h0[0], h0[1]); g.y = cvt_pk_bf16(h0[2], h0[3]); g.z = cvt_pk_bf16(h1[0], h1[1]); g.w = cvt_pk_bf16(h1[2], h1[3]);
                        *(u32x4*)(H_b + (row * 2048u + (col0 + 128u * bj) * 2u)) = g; } }
        }
    }
};
template <class Epi, class Sched, bool ALIGN_EPI = false, bool SP2 = false>
__device__ __forceinline__ void gemm_phase(PG8_LAS unsigned char* lds, const Gemm g, const Sched& S, const Epi& E, const int wave_id) {
    int tid_; asm volatile("v_mbcnt_lo_u32_b32 %0, -1, 0\n\tv_mbcnt_hi_u32_b32 %0, -1, %0" : "=v"(tid_)); tid_ += 64 * wave_id;
    const int tid = tid_, wid = __builtin_amdgcn_readfirstlane(tid >> 6), lane = tid & 63, wr = wid >> 2, wc = wid & 3, fr = lane & 15, fq = lane >> 4;
    const int K = g.K, nt = K / BK;
    unsigned voffA[2], voffB[2];
#pragma unroll
    for (int i = 0; i < 2; ++i) { int R, C; stage_rc(tid * 16 + i * 8192, R, C); const int Rb = Epi::PERM ? ((R & ~31) + perm32(R & 31)) : R;
        voffA[i] = (unsigned)(R * K + C) * 2u; voffB[i] = (unsigned)(Rb * K + C) * 2u; }
    const size_t kstep = (size_t)(BK * 2);
    const size_t hstep = (size_t)HALF * K * 2;
    const size_t tstep = 2 * hstep;
    const unsigned ldsw = (unsigned)wid * 1024u;
    const int aoff = lds_byte(wr * 64 + fr, fq * 8), boff = lds_byte(wc * 32 + fr, fq * 8);
#define PG8_SA(b, h) (((b) * 2 + (h)) * HTB)
#define PG8_SB(b, h) ((4 + (b) * 2 + (h)) * HTB)
#define PG8_STAGE(bufoff, gbase, voff) do { _Pragma("unroll") for (int _i = 0; _i < 2; ++_i) \
        __builtin_amdgcn_global_load_lds((const unsigned*)((const char*)(gbase) + (voff)[_i]), (PG8_LAS unsigned*)(lds + (bufoff) + ldsw + _i * 8192), 16, 0, 0); } while (0)
#define PG8_LDA(dst, b, h) do { _Pragma("unroll") for (int m = 0; m < 4; ++m) _Pragma("unroll") for (int k = 0; k < 2; ++k) dst[m][k] = *(const PG8_LAS bf16x8*)(lds + PG8_SA(b, h) + aoff + m * 2048 + k * 1024); } while (0)
#define PG8_LDB(dst, b, h) do { _Pragma("unroll") for (int n = 0; n < 2; ++n) _Pragma("unroll") for (int k = 0; k < 2; ++k) dst[n][k] = *(const PG8_LAS bf16x8*)(lds + PG8_SB(b, h) + boff + n * 2048 + k * 1024); } while (0)
#define PG8_MMA(ai, bj, At, Bt) do { __builtin_amdgcn_s_setprio(1); _Pragma("unroll") for (int m = 0; m < 4; ++m) _Pragma("unroll") for (int n = 0; n < 2; ++n) _Pragma("unroll") for (int k = 0; k < 2; ++k) \
        acc[ai][bj][m][n] = __builtin_amdgcn_mfma_f32_16x16x32_bf16(Bt[n][k], At[m][k], acc[ai][bj][m][n], 0, 0, 0); __builtin_amdgcn_s_setprio(0); } while (0)
#define PG8_WAIT_V(n) asm volatile("s_waitcnt vmcnt(" #n ")" ::: "memory")
#define PG8_WAIT_L(n) asm volatile("s_waitcnt lgkmcnt(" #n ")" ::: "memory")
#define PG8_BAR __builtin_amdgcn_s_barrier()
#define PG8_SCHED __builtin_amdgcn_sched_barrier(0)
    Unit cur, nxt; int ui = 0;
    if (!S.next(0, cur)) return;
    f32x4 acc[2][2][4][2];
#pragma unroll
    for (int a = 0; a < 2; ++a)
#pragma unroll
        for (int b = 0; b < 2; ++b)
#pragma unroll
            for (int m = 0; m < 4; ++m)
#pragma unroll
                for (int n = 0; n < 2; ++n) acc[a][b][m][n] = (f32x4){0.f, 0.f, 0.f, 0.f};
    bf16x8 At[4][2], B0[2][2], B1[2][2];
    const char* cA = (const char*)g.A + (size_t)cur.pm * tstep; const char* cB = (const char*)g.Bt + (size_t)cur.pn * tstep;
    S.a_ready(cur);
    if constexpr (SP2) {
        PG8_STAGE(PG8_SB(0, 0), cB, voffB); PG8_STAGE(PG8_SB(0, 1), cB + hstep, voffB); PG8_STAGE(PG8_SA(0, 0), cA, voffA); PG8_STAGE(PG8_SA(0, 1), cA + hstep, voffA);
        if (wr == 1) PG8_BAR;
        PG8_WAIT_V(2); PG8_BAR;
        PG8_STAGE(PG8_SB(1, 0), cB + kstep, voffB); PG8_STAGE(PG8_SA(1, 0), cA + kstep, voffA); PG8_STAGE(PG8_SB(1, 1), cB + hstep + kstep, voffB);
        PG8_WAIT_V(6); PG8_BAR;
    } else {
        PG8_STAGE(PG8_SB(0, 0), cB, voffB); PG8_STAGE(PG8_SA(0, 0), cA, voffA); PG8_STAGE(PG8_SB(0, 1), cB + hstep, voffB); PG8_STAGE(PG8_SA(0, 1), cA + hstep, voffA);
        if (wr == 1) PG8_BAR;
        PG8_WAIT_V(4); PG8_BAR;
        PG8_STAGE(PG8_SB(1, 0), cB + kstep, voffB); PG8_STAGE(PG8_SA(1, 0), cA + kstep, voffA); PG8_STAGE(PG8_SB(1, 1), cB + hstep + kstep, voffB);
        PG8_WAIT_V(6); PG8_BAR;
    }
    for (;;) {
        const bool has_next = S.next(ui + 1, nxt);
        const char* nA = has_next ? (const char*)g.A + (size_t)nxt.pm * tstep : cA; const char* nB = has_next ? (const char*)g.Bt + (size_t)nxt.pn * tstep : cB;
        for (int t = 0; t < nt; t += 2) {
            const bool last = (t == nt - 2);
            const char* a1 = cA + (size_t)(t + 1) * kstep;
            const char* a2 = last ? nA : cA + (size_t)(t + 2) * kstep; const char* b2 = last ? nB : cB + (size_t)(t + 2) * kstep;
            const char* a3 = a2 + kstep; const char* b3 = b2 + kstep;
            if (last && has_next) S.a_ready(nxt);
            if constexpr (SP2) {
            PG8_LDB(B0, 0, 0); PG8_LDB(B1, 0, 1); PG8_SCHED; PG8_LDA(At, 0, 0); PG8_STAGE(PG8_SA(1, 1), a1 + hstep, voffA);
            PG8_WAIT_V(8); PG8_WAIT_L(0); PG8_BAR; PG8_MMA(0, 0, At, B0); PG8_MMA(0, 1, At, B1); PG8_BAR; PG8_SCHED;
            PG8_LDA(At, 0, 1); PG8_STAGE(PG8_SB(0, 0), b2, voffB); PG8_STAGE(PG8_SB(0, 1), b2 + hstep, voffB); PG8_STAGE(PG8_SA(0, 0), a2, voffA);
            PG8_WAIT_V(8); PG8_WAIT_L(0); PG8_BAR; PG8_MMA(1, 0, At, B0); PG8_MMA(1, 1, At, B1); PG8_BAR; PG8_SCHED;
            PG8_LDB(B0, 1, 0); PG8_LDB(B1, 1, 1); PG8_SCHED; PG8_LDA(At, 1, 0); PG8_STAGE(PG8_SA(0, 1), a2 + hstep, voffA);
            PG8_WAIT_V(8); PG8_WAIT_L(0); PG8_BAR; PG8_MMA(0, 0, At, B0); PG8_MMA(0, 1, At, B1); PG8_BAR; PG8_SCHED;
            PG8_LDA(At, 1, 1); PG8_STAGE(PG8_SB(1, 0), b3, voffB); PG8_STAGE(PG8_SB(1, 1), b3 + hstep, voffB); PG8_STAGE(PG8_SA(1, 0), a3, voffA);
            PG8_WAIT_V(8); PG8_WAIT_L(0); PG8_BAR; PG8_MMA(1, 0, At, B0); PG8_MMA(1, 1, At, B1); PG8_BAR; PG8_SCHED;
            } else {
            PG8_LDB(B0, 0, 0); PG8_SCHED; PG8_LDA(At, 0, 0); PG8_STAGE(PG8_SA(1, 1), a1 + hstep, voffA);
            PG8_WAIT_L(8); PG8_BAR; PG8_WAIT_L(0); PG8_MMA(0, 0, At, B0); PG8_BAR; PG8_SCHED;
            PG8_LDB(B1, 0, 1); PG8_STAGE(PG8_SB(0, 0), b2, voffB);
            PG8_BAR; PG8_WAIT_L(0); PG8_MMA(0, 1, At, B1); PG8_BAR;
            PG8_LDA(At, 0, 1); PG8_STAGE(PG8_SA(0, 0), a2, voffA);
            PG8_BAR; PG8_WAIT_L(0); PG8_MMA(1, 0, At, B0); PG8_BAR; PG8_SCHED;
            PG8_STAGE(PG8_SB(0, 1), b2 + hstep, voffB);
            PG8_WAIT_V(6); PG8_BAR; PG8_MMA(1, 1, At, B1); PG8_BAR;
            PG8_LDB(B0, 1, 0); PG8_SCHED; PG8_LDA(At, 1, 0); PG8_STAGE(PG8_SA(0, 1), a2 + hstep, voffA);
            PG8_WAIT_L(8); PG8_BAR; PG8_WAIT_L(0); PG8_MMA(0, 0, At, B0); PG8_BAR; PG8_SCHED;
            PG8_LDB(B1, 1, 1); PG8_STAGE(PG8_SB(1, 0), b3, voffB);
            PG8_BAR; PG8_WAIT_L(0); PG8_MMA(0, 1, At, B1); PG8_BAR;
            PG8_LDA(At, 1, 1); PG8_STAGE(PG8_SA(1, 0), a3, voffA);
            PG8_BAR; PG8_WAIT_L(0); PG8_MMA(1, 0, At, B0); PG8_BAR; PG8_SCHED;
            PG8_STAGE(PG8_SB(1, 1), b3 + hstep, voffB);
            PG8_WAIT_V(6); PG8_BAR; PG8_MMA(1, 1, At, B1); PG8_BAR;
            }
        }
        if constexpr (ALIGN_EPI) { if (wr == 0) PG8_BAR; }
        if constexpr (!Epi::AFTER_DRAIN) { E(acc, cur, wr, wc, fr, fq); S.done(cur); }
        if (!has_next) break;
#pragma unroll
        for (int a = 0; a < 2; ++a)
#pragma unroll
            for (int b = 0; b < 2; ++b)
#pragma unroll
                for (int m = 0; m < 4; ++m)
#pragma unroll
                    for (int n = 0; n < 2; ++n) acc[a][b][m][n] = (f32x4){0.f, 0.f, 0.f, 0.f};
        cur = nxt; cA = nA; cB = nB; ++ui;
        if constexpr (ALIGN_EPI) { if (wr == 1) PG8_BAR; }
    }
    PG8_WAIT_V(0);
    if constexpr (!ALIGN_EPI) { if (wr == 0) PG8_BAR; }
    PG8_BAR;
    if constexpr (Epi::AFTER_DRAIN) { E.fused(acc, cur, wr, wc, fr, fq, lds, wid, lane); S.done(cur); }
#undef PG8_SA
#undef PG8_SB
#undef PG8_STAGE
#undef PG8_LDA
#undef PG8_LDB
#undef PG8_MMA
#undef PG8_WAIT_V
#undef PG8_WAIT_L
#undef PG8_BAR
#undef PG8_SCHED
}
}

#define LAS __attribute__((address_space(3)))
typedef unsigned short bf16_t;
typedef short bf16x8 __attribute__((ext_vector_type(8)));
typedef float f32x4 __attribute__((ext_vector_type(4)));
typedef unsigned u32x4 __attribute__((ext_vector_type(4)));
typedef unsigned u32x2 __attribute__((ext_vector_type(2)));

constexpr int SEQ = 16384, DM = 1024, NPROJ = 3840, LDP = 3904, DFF = 2816, NLAYER = 4, NIN = 3668;
constexpr int NWAVES = 8, NTHR = 512;
constexpr float EPSN = 1e-6f;
constexpr int PC_MQ = 0, PC_MK = 256, PC_MV = 512, PC_MO = 768, PC_AQ = 1024, PC_AK = 1280, PC_AV = 1536, PC_IQ = 1792, PC_SZ = 2048, PC_XBC = 2560, PC_IK = 3584;
constexpr int NPH = 1 + 9 * NLAYER;

constexpr size_t MiB = 1u << 20;
constexpr size_t WS_CTL = 0;
constexpr size_t WS_CS = 1 * MiB;
constexpr size_t WS_GATES = 2 * MiB;
constexpr size_t WS_SMALL = 4 * MiB;
constexpr size_t WS_WIN = 5 * MiB;
constexpr size_t WS_WOUT = WS_WIN + 3840ull * 1024 * 2;
constexpr size_t WS_WGU = WS_WOUT + 1024ull * 1024 * 2;
constexpr size_t WS_WDN = WS_WGU + 5632ull * 1024 * 2;
constexpr size_t WS_H = 32 * MiB;
constexpr size_t WS_MST = WS_H;
constexpr size_t WS_SEL = WS_H + 17 * MiB;
constexpr size_t WS_R2 = 64 * MiB;
constexpr size_t WS_MIX = WS_R2, WS_SST = WS_R2 + 32 * MiB;
constexpr size_t WS_HX = WS_MIX;
constexpr size_t WS_R1 = 128 * MiB;
constexpr size_t WS_IKC = 250 * MiB;
constexpr size_t WS_PSS = 252 * MiB;
constexpr size_t WS_END = 253 * MiB;
static_assert(WS_WDN + 1024ull * 2816 * 2 <= WS_H, "weights");
constexpr size_t WS_WDN2 = WS_H + 9 * MiB;
static_assert(WS_WDN2 + 1024ull * 2816 * 2 <= WS_SEL && WS_MST + 256ull * 4 * 65 * 64 * 2 <= WS_WDN2, "Wdown 2");
constexpr int SM_BLAST = 0, SM_MLOC = 1024, SM_M = 2048, SM_ALAST = 3072  , SM_SELCNT = 8192  ;

constexpr int LDS_BYTES = 147456;

struct Ctx {
    LAS unsigned char* lds; int tid, lane, wave, G, bid;
    int vb, xmode;
    const float* x_in; const int* pos; const float *norm_w, *w_in, *gate_b, *mnorm_w, *conv_w, *conv_b, *dt_bias, *a_log, *d_skip, *snorm_w, *w_out, *w_gate, *w_up, *w_down;
    float* out; unsigned char* ws;
};

__device__ __forceinline__ unsigned f2bf(float f) { unsigned u = __float_as_uint(f); return (u + 0x7fffu + ((u >> 16) & 1u)) >> 16; }
__device__ __forceinline__ float bf2f(unsigned h) { return __uint_as_float(h << 16); }
__device__ __forceinline__ unsigned pk2(float lo, float hi) { return f2bf(lo) | (f2bf(hi) << 16); }
__device__ __forceinline__ float bflo(unsigned w) { return __uint_as_float(w << 16); }
__device__ __forceinline__ float bfhi(unsigned w) { return __uint_as_float(w & 0xffff0000u); }
#define LDS_WAIT() asm volatile("s_waitcnt lgkmcnt(0)" ::: "memory")
__device__ __forceinline__ int opaque_v(int v) { asm volatile("" : "+v"(v)); return v; }
#define DPPF(v, ctrl) __builtin_bit_cast(float, __builtin_amdgcn_update_dpp(0, __builtin_bit_cast(int, (v)), ctrl, 0xF, 0xF, true))
__device__ __forceinline__ float row16_sum(float v) { v += DPPF(v, 0xB1); v += DPPF(v, 0x4E); v += DPPF(v, 0x141); v += DPPF(v, 0x140); return v; }
__device__ __forceinline__ float row16_max(float v) { v = fmaxf(v, DPPF(v, 0xB1)); v = fmaxf(v, DPPF(v, 0x4E)); v = fmaxf(v, DPPF(v, 0x141)); v = fmaxf(v, DPPF(v, 0x140)); return v; }
__device__ __forceinline__ float rl_f(float v, int l) { return __builtin_bit_cast(float, __builtin_amdgcn_readlane(__builtin_bit_cast(int, v), l)); }
__device__ __forceinline__ float wave_sum(float v) { v = row16_sum(v); return (rl_f(v, 0) + rl_f(v, 16)) + (rl_f(v, 32) + rl_f(v, 48)); }
__device__ __forceinline__ float wave_max(float v) { v = row16_max(v); return fmaxf(fmaxf(rl_f(v, 0), rl_f(v, 16)), fmaxf(rl_f(v, 32), rl_f(v, 48))); }
__device__ __forceinline__ float wave_scan_incl(float v, int lane) {
#pragma unroll
    for (int o = 1; o < 64; o <<= 1) { const float t = __builtin_bit_cast(float, __builtin_amdgcn_ds_bpermute(((lane - o) & 63) * 4, __builtin_bit_cast(int, v))); if (lane >= o) v += t; }
    return v;
}
__device__ __forceinline__ float lane_bcast(float v, int src) { return __builtin_bit_cast(float, __builtin_amdgcn_ds_bpermute(src * 4, __builtin_bit_cast(int, v))); }
__device__ __forceinline__ float xshfl_f(float v, int lane, int o) { return __builtin_bit_cast(float, __builtin_amdgcn_ds_bpermute((lane ^ o) * 4, __builtin_bit_cast(int, v))); }
__device__ __forceinline__ float softplus_f(float y) { return y > 20.0f ? y : log1pf(expf(y)); }
__device__ __forceinline__ float sigmoid_f(float z) { return __builtin_amdgcn_rcpf(1.0f + __expf(-z)); }

#define MFMA16(a, b, c) __builtin_amdgcn_mfma_f32_16x16x32_bf16(a, b, c, 0, 0, 0)
__device__ __forceinline__ bf16x8 ldN(const LAS bf16_t* base, int ld, int lane) { return *(const LAS bf16x8*)(base + (lane & 15) * ld + 8 * (lane >> 4)); }
__device__ __forceinline__ bf16x8 ldT(const LAS bf16_t* base, int ld, int lane) {
    const LAS bf16_t* p = base + (8 * (lane >> 4)) * ld + (lane & 15); bf16x8 v;
#pragma unroll
    for (int j = 0; j < 8; ++j) v[j] = (short)p[j * ld];
    return v;
}
__device__ __forceinline__ bf16x8 ones_frag(int lane) { const short o = (lane & 15) == 0 ? (short)0x3F80 : (short)0; return (bf16x8){o, o, o, o, o, o, o, o}; }
__device__ __forceinline__ f32x4 zero4() { return (f32x4){0.f, 0.f, 0.f, 0.f}; }

#define XB_TMO      128
#define XB_XCNT(j)  (256  + 64 * (j))
#define XB_XSUB(j)  (1280 + 64 * (j))
#define XB_XGEN(j)  (2304 + 64 * (j))
#define XB_TOP      3328
#define XB_TOPGEN   3392
#define XCD_BAR_WORDS 3456
#define XB_SPIN_CAP (1u << 18)

__device__ __forceinline__ unsigned xb_ld(unsigned* p)              { return __hip_atomic_load(p, __ATOMIC_RELAXED, __HIP_MEMORY_SCOPE_AGENT); }
__device__ __forceinline__ unsigned xb_add(unsigned* p, unsigned v) { return __hip_atomic_fetch_add(p, v, __ATOMIC_RELAXED, __HIP_MEMORY_SCOPE_AGENT); }
__device__ __forceinline__ unsigned xb_xcc_id() { return (unsigned)__builtin_amdgcn_s_getreg((3 << 11) | 20) & 0xFu; }
#define XB_SPIN(cond, bar) do { unsigned _sp = 0; while (cond) { __builtin_amdgcn_s_sleep(1); \
    if ((++_sp & 255u) == 0u) { if (xb_ld(&(bar)[XB_TMO])) break; if (_sp > XB_SPIN_CAP) { atomicAdd(&(bar)[XB_TMO], 1u); break; } } } } while (0)

struct XcdBarrier {
    unsigned* bar; unsigned x;
    volatile LAS unsigned* st;
};

__device__ __forceinline__ XcdBarrier xcd_barrier_post(unsigned* bar, volatile LAS unsigned* st, const bool is_t0) {
    XcdBarrier b; b.bar = bar; b.x = xb_xcc_id(); b.st = st;
    if (is_t0) st[2] = xb_add(&bar[XB_XCNT(b.x)], 1u);
    return b;
}
__device__ __forceinline__ void xcd_barrier_complete(unsigned* bar, unsigned x, unsigned& nloc, unsigned& nx) {
    const unsigned G = gridDim.x * gridDim.y * gridDim.z;
    unsigned sum, cnt, mine, sp = 0u;
    for (;;) {
        sum = 0u; cnt = 0u; mine = 0u;
#pragma unroll
        for (unsigned j = 0; j < 16; ++j) { const unsigned c = xb_ld(&bar[XB_XCNT(j)]); sum += c; cnt += (c > 0u) ? 1u : 0u; mine = (j == x) ? c : mine; }
        if (sum == G) break;
        __builtin_amdgcn_s_sleep(1);
        if ((++sp & 255u) == 0u) { if (xb_ld(&bar[XB_TMO])) break; if (sp > XB_SPIN_CAP) { atomicAdd(&bar[XB_TMO], 1u); break; } }
    }
    nloc = mine > 0u ? mine : 1u; nx = cnt > 0u ? cnt : 1u;
}
__device__ __forceinline__ unsigned xcd_census_even(unsigned* bar) {
    const unsigned G = gridDim.x * gridDim.y * gridDim.z; unsigned ok = (G % 8u == 0u) ? 1u : 0u;
#pragma unroll
    for (unsigned j = 0; j < 16; ++j) { const unsigned c = xb_ld(&bar[XB_XCNT(j)]); ok &= (c == (j < 8u ? G / 8u : 0u)) ? 1u : 0u; }
    return ok;
}

__device__ __forceinline__ void xcd_barrier(const XcdBarrier& b, const bool is_t0, const bool inv_wave = false, const bool early_inv = false, const bool no_release = false) {
    asm volatile("s_waitcnt vmcnt(0)" ::: "memory");
    __syncthreads();
    if (early_inv && inv_wave) { __builtin_amdgcn_fence(__ATOMIC_ACQUIRE, "agent"); asm volatile("s_waitcnt vmcnt(0)" ::: "memory"); }
    if (is_t0) {
        unsigned* bar = b.bar;
        __builtin_amdgcn_s_waitcnt(0);
        unsigned nloc = b.st[0], nx = b.st[1];
        if (nloc == 0u) { xcd_barrier_complete(bar, b.x, nloc, nx); b.st[0] = nloc; b.st[1] = nx; b.st[3] = xcd_census_even(bar); }
        const unsigned old = xb_add(&bar[XB_XSUB(b.x)], 1u);
        const unsigned gen = old / nloc;
        if (old + 1u == (gen + 1u) * nloc) {
            if (!no_release) __builtin_amdgcn_fence(__ATOMIC_RELEASE, "agent");
            asm volatile("s_waitcnt vmcnt(0)" ::: "memory");
            const unsigned og = xb_add(&bar[XB_TOP], 1u);
            const unsigned tg = og / nx;
            if (og + 1u != (tg + 1u) * nx) XB_SPIN(xb_ld(&bar[XB_TOP]) < (tg + 1u) * nx, bar);
            if (!early_inv) __builtin_amdgcn_fence(__ATOMIC_ACQUIRE, "agent");
            xb_add(&bar[XB_XGEN(b.x)], 1u);
            asm volatile("s_waitcnt vmcnt(0)" ::: "memory");
        } else {
            XB_SPIN(xb_ld(&bar[XB_XGEN(b.x)]) == gen, bar);
            if (!early_inv) __builtin_amdgcn_fence(__ATOMIC_ACQUIRE, "agent");
            asm volatile("s_waitcnt vmcnt(0)" ::: "memory");
        }
    }
    __syncthreads();
}

#define XB_LSUB(j)  (3456 + 64 * (j))
#define XB_LGEN(j)  (4480 + 64 * (j))
__device__ __forceinline__ void xcd_local_sync(const XcdBarrier& b, const bool is_t0) {
    __syncthreads();
    if (is_t0) {
        unsigned* bar = b.bar;
        unsigned nloc = b.st[0], nx = b.st[1];
        if (nloc == 0u) { xcd_barrier_complete(bar, b.x, nloc, nx); b.st[0] = nloc; b.st[1] = nx; b.st[3] = xcd_census_even(bar); }
        const unsigned old = xb_add(&bar[XB_LSUB(b.x)], 1u);
        const unsigned gen = old / nloc;
        if (old + 1u != (gen + 1u) * nloc) XB_SPIN(xb_ld(&bar[XB_LSUB(b.x)]) < (gen + 1u) * nloc, bar);
    }
    __syncthreads();
}

__device__ __forceinline__ void xcd_local_seam(const XcdBarrier& b, const bool is_t0, const bool inv_wave = false, const bool early_inv = false) {
    asm volatile("s_waitcnt vmcnt(0)" ::: "memory");
    __syncthreads();
    if (early_inv && inv_wave) { __builtin_amdgcn_fence(__ATOMIC_ACQUIRE, "agent"); asm volatile("s_waitcnt vmcnt(0)" ::: "memory"); }
    if (is_t0) {
        unsigned* bar = b.bar;
        const unsigned nloc = b.st[0];
        const unsigned old = xb_add(&bar[XB_LSUB(b.x)], 1u);
        const unsigned gen = old / nloc;
        if (old + 1u != (gen + 1u) * nloc) XB_SPIN(xb_ld(&bar[XB_LSUB(b.x)]) < (gen + 1u) * nloc, bar);
        if (!early_inv) { __builtin_amdgcn_fence(__ATOMIC_ACQUIRE, "agent");
            asm volatile("s_waitcnt vmcnt(0)" ::: "memory"); }
    }
    __syncthreads();
}

template <bool WTS = false>
__device__ __forceinline__ void transpose_item(const float* colp4, int ldw, bf16_t* WT, int K, int n0, int k0, LAS float* scr, int lane) {
    f32x4 v[8];
#pragma unroll
    for (int i = 0; i < 8; ++i) v[i] = colp4 ? *(const f32x4*)(colp4 + (size_t)(k0 + 8 * i + (lane >> 3)) * ldw) : (f32x4){0.f, 0.f, 0.f, 0.f};
#pragma unroll
    for (int i = 0; i < 8; ++i) *(LAS f32x4*)(scr + (8 * i + (lane >> 3)) * 36 + 4 * (lane & 7)) = v[i];
    LDS_WAIT();
    const int c = lane & 7;
#pragma unroll
    for (int j = 0; j < 4; ++j) { const int n = (lane >> 3) + 8 * j; const LAS float* s = scr + (8 * c) * 36 + n;
        u32x4 o; o.x = pk2(s[0 * 36], s[1 * 36]); o.y = pk2(s[2 * 36], s[3 * 36]); o.z = pk2(s[4 * 36], s[5 * 36]); o.w = pk2(s[6 * 36], s[7 * 36]);
        if (WTS) pg8::st16_wt(WT + (size_t)(n0 + n) * K + k0 + 8 * c, o); else *(u32x4*)(WT + (size_t)(n0 + n) * K + k0 + 8 * c) = o; }
    LDS_WAIT();
}
__device__ __forceinline__ int proj_src(int n) {
    if (n < 1024) return n;
    if (n < 1792) return n + 8;
    if (n < 2048) return 1800 + (n - 1792);
    if (n < 2560) return 2124 + (n - 2048);
    if (n < 3584) return 2636 + (n - 2560);
    if (n < 3648) return 2056 + (n - 3584);
    if (n < 3656) return 1024 + (n - 3648);
    if (n < 3660) return 2120 + (n - 3656);
    if (n < 3668) return n;
    return -1;
}
constexpr int CV_IN = 16 * 120, CV_OUT = CV_IN + 16 * 32, CV_GU = CV_OUT + 16 * 176, CV_ALL = CV_GU + 44 * 32;
template <bool WTS = false>
__device__ __forceinline__ void convert_layer(const Ctx& X, int l, int it_lo, int it_hi, int wid, int nw) {
    LAS float* scr = (LAS float*)(X.lds + X.wave * 16384);
    const int gw = wid * NWAVES + X.wave, NGW = nw * NWAVES, lane = X.lane;
    bf16_t* WinT = (bf16_t*)(X.ws + WS_WIN); bf16_t* WoutT = (bf16_t*)(X.ws + WS_WOUT); bf16_t* WguT = (bf16_t*)(X.ws + WS_WGU); bf16_t* WdnT = (bf16_t*)(X.ws + ((l & 1) ? WS_WDN2 : WS_WDN));
    constexpr int I_IN = 16 * 120, I_OUT = 16 * 32, I_GU = 16 * 176, I_DN = 44 * 32, NIT = I_IN + I_OUT + I_GU + I_DN;
    for (int it = it_lo + gw; it < it_hi; it += NGW) {
        int r = it;
        if (r < I_IN) { const int kb = r / 120, nb = r % 120; const int src = proj_src(nb * 32 + 4 * (lane & 7));
            const float* colp = src >= 0 ? X.w_in + (size_t)l * 1024 * NIN + src : nullptr;
            transpose_item<WTS>(colp, NIN, WinT, 1024, nb * 32, kb * 64, scr, lane); continue; }
        r -= I_IN;
        if (r < I_OUT) { const int kb = r / 32, nb = r % 32;
            transpose_item<WTS>(X.w_out + (size_t)l * 1024 * 1024 + nb * 32 + 4 * (lane & 7), 1024, WoutT, 1024, nb * 32, kb * 64, scr, lane); continue; }
        r -= I_OUT;
        if (r < I_GU) { const int kb = r / 176, nb = r % 176; const int n = nb * 32 + 4 * (lane & 7), pn = n >> 8, rr = n & 255;
            const float* colp = (rr < 128 ? X.w_gate : X.w_up) + (size_t)l * 1024 * DFF + pn * 128 + (rr & 127);
            transpose_item<WTS>(colp, DFF, WguT, 1024, nb * 32, kb * 64, scr, lane); continue; }
        r -= I_GU;
        { const int kb = r / 32, nb = r % 32;
            transpose_item<WTS>(X.w_down + (size_t)l * DFF * 1024 + nb * 32 + 4 * (lane & 7), 1024, WdnT, DFF, nb * 32, kb * 64, scr, lane); }
    }
}
__device__ __forceinline__ void p0_prologue(const Ctx& X) {
    convert_layer(X, 0, 0, CV_IN, X.bid, X.G);
    float* cs = (float*)(X.ws + WS_CS);
    const float invf[8] = {1.0f, 0.1939227432012558f, 0.03760603070259094f, 0.007292664609849453f, 0.0014142135623842478f, 0.00027424818836152554f, 5.318296098266728e-05f, 1.0313386155758053e-05f};
    for (int g = X.bid * NTHR + X.tid; g < SEQ * 8; g += X.G * NTHR) {
        const int t = g >> 3, i = g & 7;
        float f = invf[0];
#pragma unroll
        for (int k = 1; k < 8; ++k) f = (i == k) ? invf[k] : f;
        const float ang = (float)X.pos[t] * f;
        double rev = (double)ang * 0.15915494309189535; rev -= rint(rev);
        const float fr = (float)rev;
        cs[t * 16 + i] = __builtin_amdgcn_cosf(fr); cs[t * 16 + 8 + i] = __builtin_amdgcn_sinf(fr);
    }
    const int gw = X.bid * NWAVES + X.wave, NGW = X.G * NWAVES, lane = X.lane;
    bf16_t* H = (bf16_t*)(X.ws + WS_HX);
    f32x4 wn[4];
#pragma unroll
    for (int j = 0; j < 4; ++j) wn[j] = ((const f32x4*)X.norm_w)[lane + 64 * j];
    f32x4 nx[4][4];
#pragma unroll
    for (int z = 0; z < 4; ++z) { const int m = (gw + z * NGW < SEQ) ? gw + z * NGW : gw; const f32x4* xr = (const f32x4*)(X.x_in + (size_t)m * DM) + lane;
#pragma unroll
        for (int j = 0; j < 4; ++j) nx[z][j] = xr[64 * j]; }
#pragma unroll 1
    for (int m0 = gw; m0 < SEQ; m0 += 4 * NGW) {
        f32x4 v[4][4];
#pragma unroll
        for (int z = 0; z < 4; ++z)
#pragma unroll
            for (int j = 0; j < 4; ++j) v[z][j] = nx[z][j];
        const int mn0 = (m0 + 4 * NGW < SEQ) ? m0 + 4 * NGW : m0;
#pragma unroll
        for (int z = 0; z < 4; ++z) { const int m = (mn0 + z * NGW < SEQ) ? mn0 + z * NGW : mn0; const f32x4* xr = (const f32x4*)(X.x_in + (size_t)m * DM) + lane;
#pragma unroll
            for (int j = 0; j < 4; ++j) nx[z][j] = xr[64 * j]; }
        asm volatile("" ::: "memory");
#pragma unroll
        for (int z = 0; z < 4; ++z) {
            const int m = m0 + z * NGW;
            if (m < SEQ) {
                float ss = 0.f;
#pragma unroll
                for (int j = 0; j < 4; ++j) ss += (v[z][j].x * v[z][j].x + v[z][j].y * v[z][j].y) + (v[z][j].z * v[z][j].z + v[z][j].w * v[z][j].w);
                const float r = rsqrtf(wave_sum(ss) * (1.0f / DM) + EPSN);
#pragma unroll
                for (int j = 0; j < 4; ++j) { const f32x4 o = v[z][j] * r * wn[j];
                    u32x2 pk; pk.x = pk2(o.x, o.y); pk.y = pk2(o.z, o.w); *(u32x2*)(H + (size_t)m * DM + 4 * (lane + 64 * j)) = pk;
                    u32x2 px; px.x = pk2(v[z][j].x, v[z][j].y); px.y = pk2(v[z][j].z, v[z][j].w); ((u32x2*)(X.out + (size_t)m * DM))[lane + 64 * j] = px; }
            }
        }
        asm volatile("" ::: "memory");
    }
}

template <bool XF32IN, bool XF32OUT>
__device__ __forceinline__ void norm_phase(const Ctx& X, const bf16_t* src, const float* xsrc, const float* nwa, const float* nwb) {
    const int gw = X.bid * NWAVES + X.wave, NGW = X.G * NWAVES, lane = X.lane;
    bf16_t* H = (bf16_t*)(X.ws + WS_HX);
    f32x4 wa[4], wb[4];
#pragma unroll
    for (int j = 0; j < 4; ++j) { wa[j] = ((const f32x4*)nwa)[lane + 64 * j]; wb[j] = nwb ? ((const f32x4*)nwb)[lane + 64 * j] : (f32x4){0.f, 0.f, 0.f, 0.f}; }
    constexpr int NR = XF32IN ? 4 : 8;
    const int rbase = X.xmode ? 2048 * (X.vb & 7) + 8 * (X.vb >> 3) + X.wave : gw, rstep = X.xmode ? 256 : NGW;
    for (int m0 = gw; m0 < SEQ; m0 += NR * NGW) {
        const int k0 = (m0 - gw) / NGW;
        u32x2 sw[NR][4]; u32x2 xw[NR][4]; f32x4 xf[XF32IN ? NR : 1][4];
#pragma unroll
        for (int z = 0; z < NR; ++z) { const int m = (m0 + z * NGW < SEQ) ? rbase + (k0 + z) * rstep : rbase + k0 * rstep;
            const u32x2* sr = (const u32x2*)(src + (size_t)m * DM) + lane; const f32x4* xr = (const f32x4*)(xsrc + (size_t)m * DM) + lane; const u32x2* xb = (const u32x2*)(xsrc + (size_t)m * DM) + lane;
#pragma unroll
            for (int j = 0; j < 4; ++j) { sw[z][j] = sr[64 * j];
                if (XF32IN) xf[XF32IN ? z : 0][j] = xr[64 * j]; else xw[z][j] = xb[64 * j]; } }
#pragma unroll
        for (int z = 0; z < NR; ++z) {
            const int m = rbase + (k0 + z) * rstep;
            if (m0 + z * NGW < SEQ) {
                f32x4 v[4], xv[4]; float ss = 0.f;
#pragma unroll
                for (int j = 0; j < 4; ++j) { const u32x2 w = sw[z][j]; v[j] = (f32x4){bflo(w.x), bfhi(w.x), bflo(w.y), bfhi(w.y)}; ss += (v[j].x * v[j].x + v[j].y * v[j].y) + (v[j].z * v[j].z + v[j].w * v[j].w);
                    if (XF32IN) xv[j] = xf[XF32IN ? z : 0][j]; else { const u32x2 q = xw[z][j]; xv[j] = (f32x4){bflo(q.x), bfhi(q.x), bflo(q.y), bfhi(q.y)}; } }
                const float r1 = rsqrtf(wave_sum(ss) * (1.0f / DM) + EPSN);
                float ss2 = 0.f;
#pragma unroll
                for (int j = 0; j < 4; ++j) { xv[j] = xv[j] + v[j] * r1 * wa[j];
                    ss2 += (xv[j].x * xv[j].x + xv[j].y * xv[j].y) + (xv[j].z * xv[j].z + xv[j].w * xv[j].w);
                    if (XF32OUT) ((f32x4*)(X.out + (size_t)m * DM))[lane + 64 * j] = xv[j];
                    else { u32x2 pk; pk.x = pk2(xv[j].x, xv[j].y); pk.y = pk2(xv[j].z, xv[j].w); ((u32x2*)(X.out + (size_t)m * DM))[lane + 64 * j] = pk; } }
                if (nwb) {
                    const float r2 = rsqrtf(wave_sum(ss2) * (1.0f / DM) + EPSN);
#pragma unroll
                    for (int j = 0; j < 4; ++j) { const f32x4 o = xv[j] * r2 * wb[j];
                        u32x2 pk; pk.x = pk2(o.x, o.y); pk.y = pk2(o.z, o.w); *(u32x2*)(H + (size_t)m * DM + 4 * (lane + 64 * j)) = pk; }
                }
            }
        }
    }
}

__device__ __forceinline__ void conv_rows4_load(const bf16_t* proj, int trow0, int ch0, u32x4 (&raw)[7]) {
#pragma unroll
    for (int r = 0; r < 7; ++r) { const int t = trow0 - 3 + r;
        raw[r] = (t >= 0) ? *(const u32x4*)(proj + (size_t)t * LDP + PC_XBC + ch0) : (u32x4){0u, 0u, 0u, 0u}; }
}
__device__ __forceinline__ void conv_rows4_apply(const u32x4 (&raw)[7], const float* cw, const float* cb, int ch0, float (&o)[4][8]) {
    float w[4][8], b[8];
#pragma unroll
    for (int j = 0; j < 4; ++j) { const f32x4 a = *(const f32x4*)(cw + j * 1024 + ch0), c = *(const f32x4*)(cw + j * 1024 + ch0 + 4);
        w[j][0] = a.x; w[j][1] = a.y; w[j][2] = a.z; w[j][3] = a.w; w[j][4] = c.x; w[j][5] = c.y; w[j][6] = c.z; w[j][7] = c.w; }
    { const f32x4 a = *(const f32x4*)(cb + ch0), c = *(const f32x4*)(cb + ch0 + 4); b[0] = a.x; b[1] = a.y; b[2] = a.z; b[3] = a.w; b[4] = c.x; b[5] = c.y; b[6] = c.z; b[7] = c.w; }
#pragma unroll
    for (int r = 0; r < 4; ++r) {
        float acc[8];
#pragma unroll
        for (int e = 0; e < 8; ++e) acc[e] = b[e];
#pragma unroll
        for (int j = 0; j < 4; ++j) { const u32x4 q = raw[r + j];
            acc[0] += w[j][0] * bflo(q.x); acc[1] += w[j][1] * bfhi(q.x); acc[2] += w[j][2] * bflo(q.y); acc[3] += w[j][3] * bfhi(q.y);
            acc[4] += w[j][4] * bflo(q.z); acc[5] += w[j][5] * bfhi(q.z); acc[6] += w[j][6] * bflo(q.w); acc[7] += w[j][7] * bfhi(q.w); }
#pragma unroll
        for (int e = 0; e < 8; ++e) o[r][e] = acc[e] * sigmoid_f(acc[e]);
    }
}
__device__ __forceinline__ void conv_rows4(const bf16_t* proj, const float* cw, const float* cb, int trow0, int ch0, float (&o)[4][8]) {
    u32x4 raw[7]; conv_rows4_load(proj, trow0, ch0, raw); conv_rows4_apply(raw, cw, cb, ch0, o);
}
__device__ __forceinline__ u32x4 pack8(const float (&v)[8], float sc) {
    u32x4 w; w.x = pk2(v[0] * sc, v[1] * sc); w.y = pk2(v[2] * sc, v[3] * sc); w.z = pk2(v[4] * sc, v[5] * sc); w.w = pk2(v[6] * sc, v[7] * sc); return w;
}
__device__ __forceinline__ u32x4 scale8(u32x4 q, float sc) {
    u32x4 w; w.x = pk2(bflo(q.x) * sc, bfhi(q.x) * sc); w.y = pk2(bflo(q.y) * sc, bfhi(q.y) * sc); w.z = pk2(bflo(q.z) * sc, bfhi(q.z) * sc); w.w = pk2(bflo(q.w) * sc, bfhi(q.w) * sc); return w;
}

__device__ __forceinline__ void b1_chunk(const Ctx& X, int l, int c) {
    const int tid = opaque_v(X.tid), lane = tid & 63, wave = X.wave, t0 = c * 64;
    const bf16_t* proj = (const bf16_t*)(X.ws + WS_R1); const float* gates = (const float*)(X.ws + WS_GATES);
    float* small = (float*)(X.ws + WS_SMALL);
    u32x4 kv[8];
    {
        LAS bf16_t* Xs = (LAS bf16_t*)(X.lds);
        LAS bf16_t* Bm = (LAS bf16_t*)(X.lds + 66560);
        LAS float* sW = (LAS float*)(X.lds + 66560 + 33792);
        u32x4 raw[3][7];
#pragma unroll
        for (int i = 0; i < 3; ++i) { const int idx = tid + NTHR * i; conv_rows4_load(proj, t0 + 4 * (idx / 96), (idx % 96) * 8, raw[i]); }
        {
            const int h = wave; const float dtb = X.dt_bias[l * 8 + h], A = -expf(X.a_log[l * 8 + h]);
            const float dt = softplus_f(gates[(size_t)(t0 + lane) * 32 + 12 + h] + dtb);
            const float ac = wave_scan_incl(dt * A, lane); const float alast = rl_f(ac, 63);
            sW[h * 64 + lane] = expf(alast - ac) * dt;
            if (lane == 63) small[SM_ALAST + c * 8 + h] = alast;
        }
        __syncthreads();
        const float* cw = X.conv_w + (size_t)l * 4 * 1024; const float* cb = X.conv_b + (size_t)l * 1024;
#pragma unroll
        for (int i = 0; i < 3; ++i) {
            const int idx = tid + NTHR * i, cgp = idx % 96, rb = idx / 96, ch0 = cgp * 8;
            float o[4][8]; conv_rows4_apply(raw[i], cw, cb, ch0, o);
#pragma unroll
            for (int r = 0; r < 4; ++r) { const int row = 4 * rb + r;
                if (ch0 < 512) { const float sc = sW[(ch0 >> 6) * 64 + row]; *(LAS u32x4*)(Xs + row * 520 + ch0) = pack8(o[r], sc); }
                else *(LAS u32x4*)(Bm + row * 264 + (ch0 - 512)) = pack8(o[r], 1.0f); }
        }
        __syncthreads();
#pragma unroll
        for (int i = 0; i < 8; ++i) {
            const int idx = tid + NTHR * i, mat = idx >> 11, rem = idx & 2047, row = rem >> 5, ch = (rem & 31) * 8;
            kv[i] = *(const u32x4*)(proj + (size_t)(t0 + row) * LDP + (mat ? PC_MV : PC_MK) + ch);
        }
        {
            const int h = wave, g = h >> 2;
            bf16_t* dst = (bf16_t*)(X.ws + WS_SST) + (size_t)(c * 8 + h) * 64 * 128;
#pragma unroll 1
            for (int nh = 0; nh < 2; ++nh) {
                f32x4 acc[4][4];
#pragma unroll
                for (int mi = 0; mi < 4; ++mi)
#pragma unroll
                    for (int ni = 0; ni < 4; ++ni) acc[mi][ni] = zero4();
#pragma unroll
                for (int ks = 0; ks < 2; ++ks) {
                    bf16x8 af[4], bfr[4];
#pragma unroll
                    for (int mi = 0; mi < 4; ++mi) af[mi] = ldT(Xs + (32 * ks) * 520 + h * 64 + 16 * mi, 520, lane);
#pragma unroll
                    for (int ni = 0; ni < 4; ++ni) bfr[ni] = ldT(Bm + (32 * ks) * 264 + g * 128 + nh * 64 + 16 * ni, 264, lane);
#pragma unroll
                    for (int mi = 0; mi < 4; ++mi)
#pragma unroll
                        for (int ni = 0; ni < 4; ++ni) acc[mi][ni] = MFMA16(bfr[ni], af[mi], acc[mi][ni]);
                }
#pragma unroll
                for (int mi = 0; mi < 4; ++mi)
#pragma unroll
                    for (int ni = 0; ni < 4; ++ni) { u32x2 o; o.x = pk2(acc[mi][ni][0], acc[mi][ni][1]); o.y = pk2(acc[mi][ni][2], acc[mi][ni][3]);
                        *(u32x2*)(dst + (16 * mi + (lane & 15)) * 128 + nh * 64 + 16 * ni + 4 * (lane >> 4)) = o; }
            }
        }
        __syncthreads();
    }
    {
        LAS bf16_t* Kw = (LAS bf16_t*)(X.lds);
        LAS bf16_t* Vm = (LAS bf16_t*)(X.lds + 33792);
        LAS float* sWm = (LAS float*)(X.lds + 67584);
        if (wave < 4) {
            const int h = wave;
            const float ipre = gates[(size_t)(t0 + lane) * 32 + h] + X.gate_b[l * 8 + h];
            const float fpre = gates[(size_t)(t0 + lane) * 32 + 4 + h] + X.gate_b[l * 8 + 4 + h];
            const float lf = -softplus_f(-fpre);
            const float b = wave_scan_incl(lf, lane); const float blast = rl_f(b, 63);
            const float logw = blast - b + ipre; const float mloc = wave_max(logw);
            sWm[h * 64 + lane] = expf(logw - mloc);
            if (lane == 0) { small[SM_BLAST + c * 4 + h] = blast; small[SM_MLOC + c * 4 + h] = mloc; }
        }
        __syncthreads();
#pragma unroll
        for (int i = 0; i < 8; ++i) {
            const int idx = tid + NTHR * i, mat = idx >> 11, rem = idx & 2047, row = rem >> 5, ch = (rem & 31) * 8;
            u32x4 v = kv[i];
            if (!mat) v = scale8(v, sWm[(ch >> 6) * 64 + row]);
            *(LAS u32x4*)((mat ? Vm : Kw) + row * 264 + ch) = v;
        }
        __syncthreads();
        {
            const int hh = wave >> 1, dh = wave & 1;
            f32x4 acc[5][2];
#pragma unroll
            for (int ei = 0; ei < 5; ++ei) { acc[ei][0] = zero4(); acc[ei][1] = zero4(); }
#pragma unroll
            for (int ks = 0; ks < 2; ++ks) {
                bf16x8 af[5], bfr[2];
#pragma unroll
                for (int ei = 0; ei < 4; ++ei) af[ei] = ldT(Vm + (32 * ks) * 264 + hh * 64 + 16 * ei, 264, lane);
                af[4] = ones_frag(lane);
#pragma unroll
                for (int ni = 0; ni < 2; ++ni) bfr[ni] = ldT(Kw + (32 * ks) * 264 + hh * 64 + dh * 32 + 16 * ni, 264, lane);
#pragma unroll
                for (int ei = 0; ei < 5; ++ei)
#pragma unroll
                    for (int ni = 0; ni < 2; ++ni) acc[ei][ni] = MFMA16(bfr[ni], af[ei], acc[ei][ni]);
            }
            bf16_t* dst = (bf16_t*)(X.ws + WS_MST) + (size_t)(c * 4 + hh) * 65 * 64;
#pragma unroll
            for (int ei = 0; ei < 5; ++ei)
#pragma unroll
                for (int ni = 0; ni < 2; ++ni) { const int e = 16 * ei + (lane & 15);
                    if (e <= 64) { u32x2 pk; pk.x = pk2(acc[ei][ni][0], acc[ei][ni][1]); pk.y = pk2(acc[ei][ni][2], acc[ei][ni][3]); *(u32x2*)(dst + e * 64 + dh * 32 + 16 * ni + 4 * (lane >> 4)) = pk; } }
        }
        __syncthreads();
    }
}

__device__ __forceinline__ unsigned mono_u(unsigned u) { return (u & 0x80000000u) ? ~u : (u | 0x80000000u); }
__device__ __forceinline__ unsigned unmono_u(unsigned k) { return (k & 0x80000000u) ? (k & 0x7fffffffu) : ~k; }
#define DPP_STEP(v, op, ctrl) op(v, __builtin_amdgcn_update_dpp(0, (int)(v), ctrl, 0xF, 0xF, true))
__device__ __forceinline__ int iadd_(int a, int b) { return a + b; }
__device__ __forceinline__ unsigned umax_(unsigned a, int b) { return a > (unsigned)b ? a : (unsigned)b; }
__device__ __forceinline__ unsigned umin_(unsigned a, int b) { return a < (unsigned)b ? a : (unsigned)b; }
__device__ __forceinline__ int wave_sum_u(int v) {
    v = DPP_STEP(v, iadd_, 0xB1); v = DPP_STEP(v, iadd_, 0x4E); v = DPP_STEP(v, iadd_, 0x141); v = DPP_STEP(v, iadd_, 0x140);
    return __builtin_amdgcn_readlane(v, 0) + __builtin_amdgcn_readlane(v, 16) + __builtin_amdgcn_readlane(v, 32) + __builtin_amdgcn_readlane(v, 48);
}
__device__ __forceinline__ unsigned wave_max_u(unsigned v) {
    v = DPP_STEP(v, umax_, 0xB1); v = DPP_STEP(v, umax_, 0x4E); v = DPP_STEP(v, umax_, 0x141); v = DPP_STEP(v, umax_, 0x140);
    const unsigned a = (unsigned)__builtin_amdgcn_readlane((int)v, 0), b = (unsigned)__builtin_amdgcn_readlane((int)v, 16), c = (unsigned)__builtin_amdgcn_readlane((int)v, 32), d = (unsigned)__builtin_amdgcn_readlane((int)v, 48);
    const unsigned ab = a > b ? a : b, cd = c > d ? c : d; return ab > cd ? ab : cd;
}
__device__ __forceinline__ unsigned wave_min_u(unsigned v) {
    v = DPP_STEP(v, umin_, 0xB1); v = DPP_STEP(v, umin_, 0x4E); v = DPP_STEP(v, umin_, 0x141); v = DPP_STEP(v, umin_, 0x140);
    const unsigned a = (unsigned)__builtin_amdgcn_readlane((int)v, 0), b = (unsigned)__builtin_amdgcn_readlane((int)v, 16), c = (unsigned)__builtin_amdgcn_readlane((int)v, 32), d = (unsigned)__builtin_amdgcn_readlane((int)v, 48);
    const unsigned ab = a < b ? a : b, cd = c < d ? c : d; return ab < cd ? ab : cd;
}
constexpr int PRUNE_SLACK = 128;
__device__ __forceinline__ int suffix_sum64(int h, int lane) {
    int S = h;
    S += __builtin_amdgcn_update_dpp(0, S, 0x101, 0xF, 0xF, true); S += __builtin_amdgcn_update_dpp(0, S, 0x102, 0xF, 0xF, true);
    S += __builtin_amdgcn_update_dpp(0, S, 0x104, 0xF, 0xF, true); S += __builtin_amdgcn_update_dpp(0, S, 0x108, 0xF, 0xF, true);
    const int r1 = __builtin_amdgcn_readlane(S, 16), r2 = __builtin_amdgcn_readlane(S, 32), r3 = __builtin_amdgcn_readlane(S, 48);
    const int row = lane >> 4;
    return S + (row == 0 ? r1 + r2 + r3 : (row == 1 ? r2 + r3 : (row == 2 ? r3 : 0)));
}
template <int NE>
__device__ __forceinline__ void topk_prune(LAS u32x2* cq, int n, LAS int* cntq, LAS float* thrq, LAS int* hist, bool final, int lane, bool dry = false) {
    unsigned sk[NE], ix[NE];
    unsigned vmax = 0u, vmin = 0xFFFFFFFFu;
#pragma unroll
    for (int i = 0; i < NE; ++i) { const int idx = lane + 64 * i; const u32x2 e = cq[idx]; const bool ok = idx < n; const unsigned m = mono_u(e.x);
        sk[i] = ok ? m : 0u; ix[i] = ok ? e.y : 0xFFFFFFFFu; const unsigned mm = ok ? m : 0xFFFFFFFFu;
        vmin = mm < vmin ? mm : vmin; vmax = sk[i] > vmax ? sk[i] : vmax; }
    const unsigned kmax = wave_max_u(vmax), kmin = wave_min_u(vmin);
    unsigned T = kmax; bool split = false;
    int need = 256, ties = n;
    if (kmax != kmin) {
        int bitpos = 32 - __clz((int)(kmax ^ kmin));
        T = bitpos == 32 ? 0u : ((kmax >> bitpos) << bitpos);
#pragma unroll 1
        while (bitpos > 0) {
            const int w = bitpos >= 8 ? 8 : bitpos, sh = bitpos - w;
            *(LAS u32x4*)(hist + 4 * lane) = (u32x4){0u, 0u, 0u, 0u};
            LDS_WAIT();
#pragma unroll
            for (int i = 0; i < NE; ++i) {
                const bool in = (lane + 64 * i < n) && (bitpos == 32 || (sk[i] >> bitpos) == (T >> bitpos));
                const unsigned bin = in ? ((sk[i] >> sh) & ((1u << w) - 1u)) : (unsigned)(256 + lane);
                __hip_atomic_fetch_add(&hist[bin], 1, __ATOMIC_RELAXED, __HIP_MEMORY_SCOPE_WORKGROUP);
            }
            LDS_WAIT();
            const u32x4 h4 = *(const LAS u32x4*)(hist + 4 * lane);
            const int hs = (int)(h4.x + h4.y + h4.z + h4.w);
            const int S = suffix_sum64(hs, lane);
            const unsigned long long m = __ballot(S >= need);
            const int Ld = 63 - __clzll(m);
            const int hv[4] = {__builtin_amdgcn_readlane((int)h4.x, Ld), __builtin_amdgcn_readlane((int)h4.y, Ld), __builtin_amdgcn_readlane((int)h4.z, Ld), __builtin_amdgcn_readlane((int)h4.w, Ld)};
            int c = __builtin_amdgcn_readlane(S, Ld) - __builtin_amdgcn_readlane(hs, Ld);
            int d = 4 * Ld, hd = hv[0], Sd;
            if (c + hv[3] >= need) { d += 3; hd = hv[3]; Sd = c + hv[3]; }
            else if (c + hv[3] + hv[2] >= need) { d += 2; hd = hv[2]; Sd = c + hv[3] + hv[2]; }
            else if (c + hv[3] + hv[2] + hv[1] >= need) { d += 1; hd = hv[1]; Sd = c + hv[3] + hv[2] + hv[1]; }
            else { Sd = c + hv[3] + hv[2] + hv[1] + hv[0]; }
            need -= Sd - hd; ties = hd;
            T |= (unsigned)d << sh; bitpos = sh;
            if (need == hd || (!final && hd <= PRUNE_SLACK)) { split = true; break; }
        }
    }
    unsigned Ilim = 0xFFFFFFFFu;
    if (!split && need < ties) {
        unsigned I = 0u;
#pragma unroll 1
        for (int bit = 13; bit >= 0; --bit) {
            const unsigned cnd = I | (1u << bit); int c = 0;
#pragma unroll
            for (int i = 0; i < NE; ++i) c += (sk[i] == T && ix[i] < cnd) ? 1 : 0;
            if (wave_sum_u(c) < need) I = cnd;
        }
        Ilim = I;
    }
    if (dry) { if (T == 0x13579bdu && Ilim == 77u) *thrq = 0.f; return; }
    int base = 0;
#pragma unroll
    for (int i = 0; i < NE; ++i) {
        const bool kp = (sk[i] > T) || (sk[i] == T && ix[i] <= Ilim);
        const unsigned long long mk = __ballot(kp);
        const int pos = base + __popcll(mk & ((1ull << lane) - 1ull));
        LAS u32x2* dst = kp ? (cq + pos) : ((LAS u32x2*)(hist + 320) + lane);
        *dst = (u32x2){unmono_u(sk[i]), ix[i]};
        base += __popcll(mk);
    }
    if (lane == 0) { *cntq = base; *thrq = __uint_as_float(unmono_u(split && T != 0u ? T - 1u : T)); }
}
__device__ __forceinline__ void write_sorted(const LAS u32x2* cq, int n, LAS unsigned* bm, unsigned short* out, int lane) {
#pragma unroll
    for (int k = 0; k < 8; ++k) bm[lane + 64 * k] = 0u;
    LDS_WAIT();
    unsigned idx[4];
#pragma unroll
    for (int k = 0; k < 4; ++k) { const int i = lane + 64 * k; idx[k] = cq[i < n ? i : 0].y;
        __hip_atomic_fetch_or(&bm[idx[k] >> 5], 1u << (idx[k] & 31), __ATOMIC_RELAXED, __HIP_MEMORY_SCOPE_WORKGROUP); }
    LDS_WAIT();
    unsigned w[8]; int c = 0;
    { const u32x4 a_ = *(const LAS u32x4*)(bm + lane * 8), b_ = *(const LAS u32x4*)(bm + lane * 8 + 4);
      w[0] = a_.x; w[1] = a_.y; w[2] = a_.z; w[3] = a_.w; w[4] = b_.x; w[5] = b_.y; w[6] = b_.z; w[7] = b_.w; }
#pragma unroll
    for (int k = 0; k < 8; ++k) c += __popc(w[k]);
    int incl = c;
#pragma unroll
    for (int o = 1; o < 64; o <<= 1) { const int t = __builtin_amdgcn_ds_bpermute(((lane - o) & 63) * 4, incl); if (lane >= o) incl += t; }
    unsigned pre[8]; { int p = incl - c;
#pragma unroll
      for (int k = 0; k < 8; ++k) { pre[k] = (unsigned)p; p += __popc(w[k]); } }
    LAS unsigned* wp = bm + 512;
    *(LAS u32x4*)(wp + lane * 8) = (u32x4){pre[0], pre[1], pre[2], pre[3]}; *(LAS u32x4*)(wp + lane * 8 + 4) = (u32x4){pre[4], pre[5], pre[6], pre[7]};
    LDS_WAIT();
    unsigned rank[4];
#pragma unroll
    for (int k = 0; k < 4; ++k) { const unsigned wd = idx[k] >> 5, bw = bm[wd], pw = wp[wd]; rank[k] = pw + (unsigned)__popc(bw & ((1u << (idx[k] & 31)) - 1u)); }
    asm volatile("" : "+v"(rank[0]), "+v"(rank[1]), "+v"(rank[2]), "+v"(rank[3]));
#pragma unroll
    for (int k = 0; k < 4; ++k) if (lane + 64 * k < n) out[rank[k]] = (unsigned short)idx[k];
    LDS_WAIT();
}
constexpr int CCAP = 1024, CAND_BYTES = 16 * CCAP * 8;
constexpr int IDX_CTL = 131072;
constexpr int SAMPLE_RANK = 112, SAMPLE_EVERY = 4, ZT_TARGET = 600;
__device__ __forceinline__ void idx_mfma(const bf16x8 (&af)[4][2], const bf16x8 (&kf)[2][2], f32x4 (&acc)[2][4]) {
#pragma unroll
    for (int s2 = 0; s2 < 2; ++s2)
#pragma unroll
        for (int mt = 0; mt < 4; ++mt) { acc[s2][mt] = MFMA16(af[mt][0], kf[s2][0], zero4()); acc[s2][mt] = MFMA16(af[mt][1], kf[s2][1], acc[s2][mt]); }
}
__device__ __forceinline__ void idx_post(const f32x4 (&acc)[2][4], const float (&wq)[4][4], const float (&th)[4], const int (&kl)[4], const int kmin,
                                         const int kb_, const int t0, const int lane, const int wave, const int pass, LAS unsigned* hst, LAS int* cnt, LAS u32x2* cand) {
    const bool diag = kb_ + 255 >= kmin;
    float sc[2][4];
#pragma unroll
    for (int s2 = 0; s2 < 2; ++s2)
#pragma unroll
        for (int mt = 0; mt < 4; ++mt) {
            const float r0 = __int_as_float(max(__float_as_int(acc[s2][mt][0]), 0)), r1 = __int_as_float(max(__float_as_int(acc[s2][mt][1]), 0));
            const float r2 = __int_as_float(max(__float_as_int(acc[s2][mt][2]), 0)), r3 = __int_as_float(max(__float_as_int(acc[s2][mt][3]), 0));
            sc[s2][mt] = __builtin_fmaf(wq[mt][3], r3, __builtin_fmaf(wq[mt][2], r2, __builtin_fmaf(wq[mt][1], r1, __builtin_fmaf(wq[mt][0], r0, 0.0f))));
        }
    if (pass == 0) {
        if (!diag) {
#pragma unroll
            for (int s2 = 0; s2 < 2; ++s2)
#pragma unroll
                for (int mt = 0; mt < 4; ++mt) { const int q = 4 * mt + (lane >> 4); const unsigned bin = mono_u(__float_as_uint(sc[s2][mt])) >> 20;
                    __hip_atomic_fetch_add(&hst[q * 2048 + (bin >> 1)], 1u << (16 * (bin & 1u)), __ATOMIC_RELAXED, __HIP_MEMORY_SCOPE_WORKGROUP); }
        } else {
#pragma unroll
            for (int s2 = 0; s2 < 2; ++s2) {
                const int key = kb_ + s2 * 128 + wave * 16 + (lane & 15);
#pragma unroll
                for (int mt = 0; mt < 4; ++mt) { const int q = 4 * mt + (lane >> 4);
                    if (key < kl[mt]) { const unsigned bin = mono_u(__float_as_uint(sc[s2][mt])) >> 20;
                        __hip_atomic_fetch_add(&hst[q * 2048 + (bin >> 1)], 1u << (16 * (bin & 1u)), __ATOMIC_RELAXED, __HIP_MEMORY_SCOPE_WORKGROUP); } }
            }
        }
        return;
    }
    if (diag) {
#pragma unroll
        for (int s2 = 0; s2 < 2; ++s2) {
            const int key = kb_ + s2 * 128 + wave * 16 + (lane & 15);
#pragma unroll
            for (int mt = 0; mt < 4; ++mt) sc[s2][mt] = (key < kl[mt]) ? sc[s2][mt] : -INFINITY;
        }
    }
    {
        int pos[2][4]; unsigned long long sv_, mk[2][4];
        const unsigned cnt_a = (unsigned)(uintptr_t)(cnt + (lane >> 4)); const int one_ = 1;
#pragma unroll
        for (int s2 = 0; s2 < 2; ++s2)
            asm volatile("v_cmp_gt_f32 %[m0], %[sc0], %[th0]\n\tv_cmp_gt_f32 %[m1], %[sc1], %[th1]\n\tv_cmp_gt_f32 %[m2], %[sc2], %[th2]\n\tv_cmp_gt_f32 %[m3], %[sc3], %[th3]\n\t"
                         "s_mov_b64 %[sv], exec\n\t"
                         "s_mov_b64 exec, %[m0]\n\tds_add_rtn_u32 %[p0], %[ad], %[one]\n\t"
                         "s_mov_b64 exec, %[m1]\n\tds_add_rtn_u32 %[p1], %[ad], %[one] offset:16\n\t"
                         "s_mov_b64 exec, %[m2]\n\tds_add_rtn_u32 %[p2], %[ad], %[one] offset:32\n\t"
                         "s_mov_b64 exec, %[m3]\n\tds_add_rtn_u32 %[p3], %[ad], %[one] offset:48\n\t"
                         "s_mov_b64 exec, %[sv]"
                         : [p0]"=&v"(pos[s2][0]), [p1]"=&v"(pos[s2][1]), [p2]"=&v"(pos[s2][2]), [p3]"=&v"(pos[s2][3]),
                           [m0]"=&s"(mk[s2][0]), [m1]"=&s"(mk[s2][1]), [m2]"=&s"(mk[s2][2]), [m3]"=&s"(mk[s2][3]), [sv]"=&s"(sv_)
                         : [sc0]"v"(sc[s2][0]), [sc1]"v"(sc[s2][1]), [sc2]"v"(sc[s2][2]), [sc3]"v"(sc[s2][3]), [th0]"v"(th[0]), [th1]"v"(th[1]), [th2]"v"(th[2]), [th3]"v"(th[3]),
                           [ad]"v"(cnt_a), [one]"v"(one_) : "memory");
        asm volatile("s_waitcnt lgkmcnt(0)" : "+v"(pos[0][0]), "+v"(pos[0][1]), "+v"(pos[0][2]), "+v"(pos[0][3]), "+v"(pos[1][0]), "+v"(pos[1][1]), "+v"(pos[1][2]), "+v"(pos[1][3]) :: "memory");
        const unsigned lb_ = (unsigned)(uintptr_t)(cand + (lane >> 4) * CCAP);
#pragma unroll
        for (int s2 = 0; s2 < 2; ++s2) {
            const unsigned key = (unsigned)(kb_ + s2 * 128 + wave * 16 + (lane & 15));
            unsigned a0_, a1_, a2_, a3_;
            asm volatile("v_and_b32 %[a0], 0x3ff, %[p0]\n\tv_and_b32 %[a1], 0x3ff, %[p1]\n\tv_and_b32 %[a2], 0x3ff, %[p2]\n\tv_and_b32 %[a3], 0x3ff, %[p3]\n\t"
                         "v_lshl_add_u32 %[a0], %[a0], 3, %[l0]\n\tv_lshl_add_u32 %[a1], %[a1], 3, %[l1]\n\tv_lshl_add_u32 %[a2], %[a2], 3, %[l2]\n\tv_lshl_add_u32 %[a3], %[a3], 3, %[l3]\n\t"
                         "s_mov_b64 %[sv], exec\n\t"
                         "s_mov_b64 exec, %[m0]\n\tds_write2_b32 %[a0], %[sc0], %[key] offset1:1\n\t"
                         "s_mov_b64 exec, %[m1]\n\tds_write2_b32 %[a1], %[sc1], %[key] offset1:1\n\t"
                         "s_mov_b64 exec, %[m2]\n\tds_write2_b32 %[a2], %[sc2], %[key] offset1:1\n\t"
                         "s_mov_b64 exec, %[m3]\n\tds_write2_b32 %[a3], %[sc3], %[key] offset1:1\n\t"
                         "s_mov_b64 exec, %[sv]"
                         : [sv]"=&s"(sv_), [a0]"=&v"(a0_), [a1]"=&v"(a1_), [a2]"=&v"(a2_), [a3]"=&v"(a3_)
                         : [m0]"s"(mk[s2][0]), [m1]"s"(mk[s2][1]), [m2]"s"(mk[s2][2]), [m3]"s"(mk[s2][3]),
                           [p0]"v"(pos[s2][0]), [p1]"v"(pos[s2][1]), [p2]"v"(pos[s2][2]), [p3]"v"(pos[s2][3]),
                           [l0]"v"(lb_), [l1]"v"(lb_ + 1 * (4 * CCAP * 8)), [l2]"v"(lb_ + 2 * (4 * CCAP * 8)), [l3]"v"(lb_ + 3 * (4 * CCAP * 8)),
                           [sc0]"v"(sc[s2][0]), [sc1]"v"(sc[s2][1]), [sc2]"v"(sc[s2][2]), [sc3]"v"(sc[s2][3]), [key]"v"(key) : "memory");
        }
    }
}
__device__ __forceinline__ void idx_window(const bf16x8 (&af)[4][2], const float (&wq)[4][4], const float (&th)[4], const int (&kl)[4], const int kmin, const bf16x8 (&kf)[2][2],
                                           const int kb_, const int t0, const int lane, const int wave, const int pass, LAS unsigned* hst, LAS int* cnt, LAS u32x2* cand) {
    f32x4 acc[2][4]; idx_mfma(af, kf, acc); idx_post(acc, wq, th, kl, kmin, kb_, t0, lane, wave, pass, hst, cnt, cand);
}
struct IdxKeys { const char* base; unsigned loff; int wmul; };
__device__ __forceinline__ void idx_load(bf16x8 (&kf)[2][2], const IdxKeys kb0, int win) {
    const char* kb = kb0.base + (size_t)(win * kb0.wmul) * (256 * 128);
    kf[0][0] = *(const bf16x8*)(kb + kb0.loff); kf[0][1] = *(const bf16x8*)(kb + 1024 + kb0.loff);
    kf[1][0] = *(const bf16x8*)(kb + 128 * 128 + kb0.loff); kf[1][1] = *(const bf16x8*)(kb + 128 * 128 + 1024 + kb0.loff);
}
__device__ __forceinline__ void idx_aload(bf16x8 (&kf)[2][2], const IdxKeys kb0, int win) {
    const char* kb = kb0.base + (size_t)(win * kb0.wmul) * (256 * 128); const char* kb1 = kb + 128 * 128;
    asm volatile("s_nop 4\n\tglobal_load_dwordx4 %0, %4, %5\n\tglobal_load_dwordx4 %1, %4, %5 offset:1024\n\tglobal_load_dwordx4 %2, %4, %6\n\tglobal_load_dwordx4 %3, %4, %6 offset:1024"
                 : "=&v"(kf[0][0]), "=&v"(kf[0][1]), "=&v"(kf[1][0]), "=&v"(kf[1][1]) : "v"(kb0.loff), "s"(kb), "s"(kb1) : "memory");
}
#define IDX_AWAIT(kf, n) asm volatile("s_waitcnt vmcnt(" #n ")" : "+v"(kf[0][0]), "+v"(kf[0][1]), "+v"(kf[1][0]), "+v"(kf[1][1]) :: "memory")
__device__ __forceinline__ void idx_stream_begin(bf16x8 (&k0)[2][2], bf16x8 (&k1)[2][2], bf16x8 (&k2)[2][2], const IdxKeys kb0, const int nwin, const int wstep) {
    const int nit = (nwin + wstep - 1) / wstep, lastw = (nit - 1) * wstep;
    idx_aload(k0, kb0, 0); idx_aload(k1, kb0, min(wstep, lastw)); idx_aload(k2, kb0, min(2 * wstep, lastw));
}
__device__ __forceinline__ void idx_stream_drain(bf16x8 (&k0)[2][2], bf16x8 (&k1)[2][2], bf16x8 (&k2)[2][2]) { asm volatile("s_waitcnt vmcnt(0)" ::: "memory"); }
__device__ __forceinline__ void idx_stream(bf16x8 (&k0)[2][2], bf16x8 (&k1)[2][2], bf16x8 (&k2)[2][2],
                                           const bf16x8 (&af)[4][2], const float (&wq)[4][4], const float (&th)[4], const int (&kl)[4], const int kmin, const IdxKeys kb0, const int nwin, const int wstep,
                                           const int t0, const int lane, const int wave, const int pass, LAS unsigned* hst, LAS int* cnt, LAS u32x2* cand) {
    const int nit = (nwin + wstep - 1) / wstep, lastw = (nit - 1) * wstep;
    bf16x8 k3[2][2];
#pragma unroll
    for (int mt = 0; mt < 4; ++mt) asm volatile("" :: "v"(af[mt][0]), "v"(af[mt][1]), "v"(wq[mt][0]), "v"(wq[mt][1]), "v"(wq[mt][2]), "v"(wq[mt][3]));
    f32x4 aA[2][4], aB[2][4];
    IDX_AWAIT(k0, 8); idx_mfma(af, k0, aA);
#pragma unroll 1
    for (int it = 0; it < nit; it += 4) {
        const int w = it * wstep;
        idx_aload(k3, kb0, min(w + 3 * wstep, lastw)); IDX_AWAIT(k1, 8);
        idx_mfma(af, k1, aB); __builtin_amdgcn_sched_barrier(0);
        idx_post(aA, wq, th, kl, kmin, w * 256, t0, lane, wave, pass, hst, cnt, cand);
        idx_aload(k0, kb0, min(w + 4 * wstep, lastw)); IDX_AWAIT(k2, 8);
        idx_mfma(af, k2, aA); __builtin_amdgcn_sched_barrier(0);
        if (it + 1 < nit) idx_post(aB, wq, th, kl, kmin, (w + wstep) * 256, t0, lane, wave, pass, hst, cnt, cand);
        idx_aload(k1, kb0, min(w + 5 * wstep, lastw)); IDX_AWAIT(k3, 8);
        idx_mfma(af, k3, aB); __builtin_amdgcn_sched_barrier(0);
        if (it + 2 < nit) idx_post(aA, wq, th, kl, kmin, (w + 2 * wstep) * 256, t0, lane, wave, pass, hst, cnt, cand);
        idx_aload(k2, kb0, min(w + 6 * wstep, lastw)); IDX_AWAIT(k0, 8);
        idx_mfma(af, k0, aA); __builtin_amdgcn_sched_barrier(0);
        if (it + 3 < nit) idx_post(aB, wq, th, kl, kmin, (w + 3 * wstep) * 256, t0, lane, wave, pass, hst, cnt, cand);
    }
    IDX_AWAIT(k0, 0); IDX_AWAIT(k1, 0); IDX_AWAIT(k2, 0); IDX_AWAIT(k3, 0);
    LDS_WAIT();
}
__device__ __forceinline__ void idx_fetch_issue(int& r, int* ctr) { const int one_ = 1; const unsigned z_ = 0u;
    asm volatile("s_nop 4\n\tglobal_atomic_add %0, %1, %2, %3 sc0" : "=&v"(r) : "v"(z_), "v"(one_), "s"(ctr) : "memory"); }
__device__ __forceinline__ void idx_fetch_wait(int& r) { asm volatile("s_waitcnt vmcnt(0)" : "+v"(r) :: "memory"); }
__device__ __forceinline__ void dsa_index_item(const Ctx& X, int item, int* ctr, LAS int* nxt) {
    const int tid = opaque_v(X.tid), lane = tid & 63, wave = X.wave, t0 = item * 16;
    const bf16_t* proj = (const bf16_t*)(X.ws + WS_R1); const float* gates = (const float*)(X.ws + WS_GATES);
    LAS u32x2* cand = (LAS u32x2*)X.lds;
    LAS unsigned* hst = (LAS unsigned*)X.lds;
    LAS int* cnt = (LAS int*)(X.lds + IDX_CTL); LAS float* thr = (LAS float*)(X.lds + IDX_CTL + 64);
    LAS int* flag3 = (LAS int*)(X.lds + IDX_CTL + 128); LAS int* failf = (LAS int*)(X.lds + IDX_CTL + 144);
    LAS int* cge = (LAS int*)(X.lds + IDX_CTL + 192);
    LAS int* hist = (LAS int*)(X.lds + IDX_CTL + 256 + wave * 1792);
    LAS int* klim = (LAS int*)(X.lds + IDX_CTL + 14720);
    unsigned short* sel = (unsigned short*)(X.ws + WS_SEL); int* selcnt = (int*)(X.ws + WS_SMALL) + SM_SELCNT;
    bf16x8 af[4][2]; float wq[4][4];
#pragma unroll
    for (int mt = 0; mt < 4; ++mt) {
        const bf16_t* b = proj + (size_t)(t0 + 4 * mt + ((lane & 15) >> 2)) * LDP + PC_IQ + 64 * (lane & 3) + 8 * (lane >> 4);
        af[mt][0] = *(const bf16x8*)b; af[mt][1] = *(const bf16x8*)(b + 32);
        const f32x4 w4 = *(const f32x4*)(gates + (size_t)(t0 + 4 * mt + (lane >> 4)) * 32 + 8);
        wq[mt][0] = w4.x; wq[mt][1] = w4.y; wq[mt][2] = w4.z; wq[mt][3] = w4.w;
    }
    const int nwin = (t0 + 15) / 256 + 1;
    const IdxKeys kb0{(const char*)(X.ws + WS_IKC) + wave * 2048, (unsigned)lane * 16u, 1};
    const int q0 = wave * 2;
    bf16x8 k0[2][2], k1[2][2], k2[2][2];
    if (t0 >= 1024) idx_stream_begin(k0, k1, k2, kb0, nwin, SAMPLE_EVERY);
    const f32x4 wv0 = *(const f32x4*)(gates + (size_t)(t0 + q0) * 32 + 8), wv1 = *(const f32x4*)(gates + (size_t)(t0 + q0 + 1) * 32 + 8);
    bool done = false, failed = false;
    int kl[4]; int kmin = t0 + 1;
#pragma unroll
    for (int mt = 0; mt < 4; ++mt) kl[mt] = t0 + 4 * mt + (lane >> 4) + 1;
    if (tid < 16) { cnt[tid] = 0; thr[tid] = -INFINITY; cge[tid] = 0; klim[tid] = t0 + tid + 1; }
    if (tid == 16) failf[0] = 0;
    int pre_ = -1;
    if (t0 >= 1024) {
        { const unsigned z_ = (unsigned)opaque_v(0);
#pragma unroll
          for (int i = 0; i < 16; ++i) ((LAS u32x4*)X.lds)[tid + NTHR * i] = (u32x4){z_, z_, z_, z_}; }
        float th[4] = {-INFINITY, -INFINITY, -INFINITY, -INFINITY};
        __syncthreads();
        if (tid == 0) *nxt = -1;
        idx_stream(k0, k1, k2, af, wq, th, kl, kmin, kb0, nwin, SAMPLE_EVERY, t0, lane, wave, 0, hst, cnt, cand);
        __syncthreads();
        asm volatile("" :: "v"(wv0), "v"(wv1));
        idx_stream_begin(k0, k1, k2, kb0, nwin, 1);
        int s_[2], S_[2];
#pragma unroll
        for (int qq = 0; qq < 2; ++qq) {
            const LAS unsigned* hq = hst + (q0 + qq) * 2048;
            int s = 0;
#pragma unroll
            for (int i = 0; i < 8; ++i) { const u32x4 v = *(const LAS u32x4*)(hq + 32 * lane + 4 * ((i + lane) & 7));
                s += (int)((v.x & 0xffffu) + (v.x >> 16) + (v.y & 0xffffu) + (v.y >> 16)) + (int)((v.z & 0xffffu) + (v.z >> 16) + (v.w & 0xffffu) + (v.w >> 16)); }
            s_[qq] = s;
        }
#pragma unroll
        for (int qq = 0; qq < 2; ++qq) S_[qq] = suffix_sum64(s_[qq], lane);
#pragma unroll
        for (int qq = 0; qq < 2; ++qq) {
            const int q = q0 + qq; const LAS unsigned* hq = hst + q * 2048;
            const int s = s_[qq], S = S_[qq];
            const int total = __builtin_amdgcn_readlane(S, 0);
            if (total >= SAMPLE_RANK) {
                const int Ls = 63 - __clzll(__ballot(S >= SAMPLE_RANK));
                const int above = __builtin_amdgcn_readlane(S - s, Ls), need = SAMPLE_RANK - above;
                const unsigned wd = hq[32 * Ls + (lane >> 1)]; const int cb = (int)((wd >> (16 * (lane & 1))) & 0xffffu);
                const int S2 = suffix_sum64(cb, lane);
                const int bj = 63 - __clzll(__ballot(S2 >= need));
                const unsigned edge = (unsigned)(64 * Ls + bj) << 20;
                const float thr0 = __uint_as_float(edge == 0x80000000u ? 0x80000001u : unmono_u(edge - 1u));
                int cq = above + __builtin_amdgcn_readlane(S2, bj);
                const f32x4 wv = qq ? wv1 : wv0;
                const int cz = __builtin_amdgcn_readlane(cb, bj);
                if (edge == 0x80000000u && above == 0 && wv.x <= 0.f && wv.y <= 0.f && wv.z <= 0.f && wv.w <= 0.f && SAMPLE_EVERY * cz > ZT_TARGET) {
                    const int kcut = (int)(((long long)total * ZT_TARGET) / cz);
                    if (lane == 0) klim[q] = min(t0 + q + 1, max(kcut, 1024));
                    cq = ZT_TARGET / SAMPLE_EVERY;
                }
                if (lane == 0) { thr[q] = thr0; cge[q] = cq; }
            }
        }
        __syncthreads();
        int mxc = 0;
#pragma unroll
        for (int i = 0; i < 16; ++i) mxc = max(mxc, cge[i]);
#ifdef FORCE_FB
        const bool fits = SAMPLE_EVERY * mxc <= 800 && (item & 31) != 9;
#else
        const bool fits = SAMPLE_EVERY * mxc <= 800;
#endif
#pragma unroll
        for (int mt = 0; mt < 4; ++mt) { th[mt] = thr[4 * mt + (lane >> 4)]; kl[mt] = klim[4 * mt + (lane >> 4)]; }
#pragma unroll
        for (int i = 0; i < 16; ++i) kmin = min(kmin, klim[i]);
        if (!fits) idx_stream_drain(k0, k1, k2);
        if (fits) {
            idx_stream(k0, k1, k2, af, wq, th, kl, kmin, kb0, nwin, 1, t0, lane, wave, 1, hst, cnt, cand);
            __syncthreads();
            int bad_ = 0;
#pragma unroll
            for (int i = 0; i < 4; ++i) {
                const u32x4 c4 = *(LAS const u32x4*)&cnt[4 * i];
#pragma unroll
                for (int j = 0; j < 4; ++j) bad_ |= (c4[j] > (unsigned)CCAP || c4[j] < 256u) ? 1 : 0;
            }
#ifdef FORCE_FB
            if ((item & 31) == 5) bad_ = 1;
#endif
            if (bad_ == 0) {
                if (tid == 0) idx_fetch_issue(pre_, ctr);
#pragma unroll 1
                for (int qq = 0; qq < 2; ++qq) {
                    const int q = q0 + qq; int n = cnt[q];
#if defined(PROBE_SUB) && PROBE_SUB == 35
                    if (n > 256) { topk_prune<16>(cand + q * CCAP, n, cnt + q, thr + q, hist, true, lane, true); LDS_WAIT(); }
#endif
                    if (n > 512) { topk_prune<16>(cand + q * CCAP, n, cnt + q, thr + q, hist, true, lane); LDS_WAIT(); n = cnt[q]; }
                    else if (n > 256) { topk_prune<8>(cand + q * CCAP, n, cnt + q, thr + q, hist, true, lane); LDS_WAIT(); n = cnt[q]; }
                    LDS_WAIT();
#if defined(PROBE_SUB) && PROBE_SUB == 36
                    write_sorted(cand + q * CCAP, n, (LAS unsigned*)(cand + q * CCAP + 512), sel + (size_t)(t0 + q) * 256, lane);
#endif
                    write_sorted(cand + q * CCAP, n, (LAS unsigned*)(cand + q * CCAP + 512), sel + (size_t)(t0 + q) * 256, lane);
                    if (lane == 0) selcnt[t0 + q] = n;
                }
                if (tid == 0) { idx_fetch_wait(pre_); *nxt = pre_; }
                done = true;
            } else failed = true;
        }
        __syncthreads();
        if (!done && tid < 16) { cnt[tid] = 0; if (failed) thr[tid] = -INFINITY; }
#pragma unroll
        for (int mt = 0; mt < 4; ++mt) kl[mt] = t0 + 4 * mt + (lane >> 4) + 1;
        kmin = t0 + 1;
    }
    if (t0 < 1024) {
        float th[4] = {-INFINITY, -INFINITY, -INFINITY, -INFINITY};
        __syncthreads();
        if (tid == 0) *nxt = -1;
        idx_stream_begin(k0, k1, k2, kb0, nwin, 1);
        idx_stream(k0, k1, k2, af, wq, th, kl, kmin, kb0, nwin, 1, t0, lane, wave, 1, hst, cnt, cand);
        __syncthreads();
        if (tid == 0) idx_fetch_issue(pre_, ctr);
#pragma unroll 1
        for (int qq = 0; qq < 2; ++qq) {
            const int q = q0 + qq; int n = cnt[q];
            if (n > 512) { topk_prune<16>(cand + q * CCAP, n, cnt + q, thr + q, hist, true, lane); LDS_WAIT(); n = cnt[q]; }
            else if (n > 256) { topk_prune<8>(cand + q * CCAP, n, cnt + q, thr + q, hist, true, lane); LDS_WAIT(); n = cnt[q]; }
            LDS_WAIT();
            write_sorted(cand + q * CCAP, n, (LAS unsigned*)(cand + q * CCAP + 512), sel + (size_t)(t0 + q) * 256, lane);
            if (lane == 0) selcnt[t0 + q] = n;
        }
        if (tid == 0) { idx_fetch_wait(pre_); *nxt = pre_; }
        done = true;
        __syncthreads();
    }
    if (!done) {
        if (tid < 3) flag3[tid] = 0;
        float th[4];
        __syncthreads();
#pragma unroll
        for (int mt = 0; mt < 4; ++mt) th[mt] = thr[4 * mt + (lane >> 4)];
        bf16x8 cur[2][2], nxt[2][2];
        idx_load(cur, kb0, 0);
#pragma unroll 1
        for (int w = 0; w < nwin; ++w) {
            const bool last = (w == nwin - 1);
            idx_load(nxt, kb0, min(w + 1, nwin - 1));
            idx_window(af, wq, th, kl, kmin, cur, w * 256, t0, lane, wave, 1, hst, cnt, cand);
            LDS_WAIT();
            __syncthreads();
            const int trig = (cnt[q0] > CCAP - 256 || cnt[q0 + 1] > CCAP - 256) ? 1 : 0;
            const int ck = w % 3;
            if (tid == 0) flag3[(ck + 1) % 3] = 0;
            if (trig && lane == 0) flag3[ck] = 1;
            __syncthreads();
            const int anyt = flag3[ck];
            if (anyt || last) {
#pragma unroll 1
                for (int qq = 0; qq < 2; ++qq) {
                    const int q = q0 + qq; int n = cnt[q];
                    if (n > 256 + PRUNE_SLACK || (last && n > 256)) { topk_prune<16>(cand + q * CCAP, n, cnt + q, thr + q, hist, last, lane); LDS_WAIT(); n = cnt[q]; }
                    if (last) {
                        LDS_WAIT();
                        write_sorted(cand + q * CCAP, n, (LAS unsigned*)(cand + q * CCAP + 512), sel + (size_t)(t0 + q) * 256, lane);
                        if (lane == 0) selcnt[t0 + q] = n;
                    }
                }
                __syncthreads();
#pragma unroll
                for (int mt = 0; mt < 4; ++mt) th[mt] = thr[4 * mt + (lane >> 4)];
            }
#pragma unroll
            for (int s4 = 0; s4 < 2; ++s4) { cur[s4][0] = nxt[s4][0]; cur[s4][1] = nxt[s4][1]; }
        }
    }
    __syncthreads();
}

__device__ __forceinline__ void b2_scan(const Ctx& X) {
    float* small = (float*)(X.ws + WS_SMALL);
    const int NT = X.G * NTHR;
    for (int g = (X.wave * X.G + X.bid) * 64 + X.lane; g < 65536 + 16640; g += NT) {
        if (g < 65536) {
            const int h = g >> 13; bf16_t* p = (bf16_t*)(X.ws + WS_SST) + g; float st = 0.f;
            unsigned short nx[8]; float nd[8];
#pragma unroll
            for (int j = 0; j < 8; ++j) { nx[j] = p[(size_t)j * 65536]; nd[j] = small[SM_ALAST + j * 8 + h]; }
#pragma unroll 1
            for (int c0 = 0; c0 < 256; c0 += 8) {
                unsigned short cu[8]; float cd[8];
#pragma unroll
                for (int j = 0; j < 8; ++j) { cu[j] = nx[j]; cd[j] = nd[j]; }
                const int cn = c0 + 8 < 256 ? c0 + 8 : c0;
#pragma unroll
                for (int j = 0; j < 8; ++j) { nx[j] = p[(size_t)(cn + j) * 65536]; nd[j] = small[SM_ALAST + (cn + j) * 8 + h]; }
                asm volatile("" ::: "memory");
#pragma unroll
                for (int j = 0; j < 8; ++j) { p[(size_t)(c0 + j) * 65536] = (bf16_t)f2bf(st); st = st * __expf(cd[j]) + bf2f(cu[j]); }
                asm volatile("" ::: "memory");
            }
        } else {
            const int q = g - 65536, h = q / 4160; bf16_t* p = (bf16_t*)(X.ws + WS_MST) + q; float st = 0.f, m = 0.f; const bool wr = (q % 4160) == 0;
            unsigned short nx[8]; float nb[8], nm[8];
#pragma unroll
            for (int j = 0; j < 8; ++j) { nx[j] = p[(size_t)j * 16640]; nb[j] = small[SM_BLAST + j * 4 + h]; nm[j] = small[SM_MLOC + j * 4 + h]; }
#pragma unroll 1
            for (int c0 = 0; c0 < 256; c0 += 8) {
                unsigned short cu[8]; float cb[8], cm[8];
#pragma unroll
                for (int j = 0; j < 8; ++j) { cu[j] = nx[j]; cb[j] = nb[j]; cm[j] = nm[j]; }
                const int cn = c0 + 8 < 256 ? c0 + 8 : c0;
#pragma unroll
                for (int j = 0; j < 8; ++j) { nx[j] = p[(size_t)(cn + j) * 16640]; nb[j] = small[SM_BLAST + (cn + j) * 4 + h]; nm[j] = small[SM_MLOC + (cn + j) * 4 + h]; }
                asm volatile("" ::: "memory");
#pragma unroll
                for (int j = 0; j < 8; ++j) {
                    const float bl = cb[j], ml = cm[j];
                    const float mn = fmaxf(bl + m, ml); const float dec = __expf(bl + m - mn), isc = __expf(ml - mn);
                    if (wr) small[SM_M + (c0 + j) * 4 + h] = m;
                    p[(size_t)(c0 + j) * 16640] = (bf16_t)f2bf(st); st = st * dec + isc * bf2f(cu[j]); m = mn; }
                asm volatile("" ::: "memory");
            }
        }
    }
}

__device__ __forceinline__ bf16x8 cvt_frag_f32(const float* p, bool ok) {
    u32x4 w = (u32x4){0u, 0u, 0u, 0u};
    if (ok) { const f32x4 a = *(const f32x4*)p, b = *(const f32x4*)(p + 4); w.x = pk2(a.x, a.y); w.y = pk2(a.z, a.w); w.z = pk2(b.x, b.y); w.w = pk2(b.z, b.w); }
    return __builtin_bit_cast(bf16x8, w);
}
__device__ __forceinline__ void b3_chunk(const Ctx& X, int l, int c) {
    const int wave = X.wave, t0 = c * 64;
    const bf16_t* proj = (const bf16_t*)(X.ws + WS_R1); const float* gates = (const float*)(X.ws + WS_GATES);
    const float* small = (const float*)(X.ws + WS_SMALL);
    bf16_t* mix = (bf16_t*)(X.ws + WS_MIX);
    const int hs = wave >> 1, rh = wave & 1;
    u32x4 rawA[7], rawB[7];
    {
        const int tid = opaque_v(X.tid), lane = tid & 63, lr = lane & 15, lq = lane >> 4, h = hs;
#pragma unroll
        for (int i = 0; i < 4; ++i) { const int idx = tid + NTHR * i, sh = idx >> 9, r2 = idx & 511, row = r2 >> 3, ch = (r2 & 7) * 8;
            *(LAS u32x4*)(X.lds + sh * 18944 + (row * 72 + ch) * 2) = *(const u32x4*)(proj + (size_t)(t0 + row) * LDP + PC_MV + sh * 64 + ch); }
        if (rh == 0) {
            const float ipre = gates[(size_t)(t0 + lane) * 32 + h] + X.gate_b[l * 8 + h];
            const float fpre = gates[(size_t)(t0 + lane) * 32 + 4 + h] + X.gate_b[l * 8 + 4 + h];
            const float b = wave_scan_incl(-softplus_f(-fpre), lane);
            ((LAS float*)(X.lds + hs * 18944 + 18432))[lane] = b; ((LAS float*)(X.lds + hs * 18944 + 18688))[lane] = ipre;
        }
        bf16x8 qf[2][2], kf[4][2], cf[5][2];
#pragma unroll
        for (int tt = 0; tt < 2; ++tt)
#pragma unroll
            for (int ks = 0; ks < 2; ++ks) qf[tt][ks] = *(const bf16x8*)(proj + (size_t)(t0 + 32 * rh + 16 * tt + lr) * LDP + PC_MQ + h * 64 + 32 * ks + 8 * lq);
#pragma unroll
        for (int ni = 0; ni < 4; ++ni)
#pragma unroll
            for (int ks = 0; ks < 2; ++ks) kf[ni][ks] = *(const bf16x8*)(proj + (size_t)(t0 + 16 * ni + lr) * LDP + PC_MK + h * 64 + 32 * ks + 8 * lq);
        const bf16_t* ctg = (const bf16_t*)(X.ws + WS_MST) + (size_t)(c * 4 + h) * 4160;
#pragma unroll
        for (int ei = 0; ei < 5; ++ei)
#pragma unroll
            for (int ks = 0; ks < 2; ++ks) cf[ei][ks] = (16 * ei + lr <= 64) ? *(const bf16x8*)(ctg + (16 * ei + lr) * 64 + 32 * ks + 8 * lq) : (bf16x8){0, 0, 0, 0, 0, 0, 0, 0};
        const float mc = small[SM_M + c * 4 + h];
        __syncthreads();
        conv_rows4_load(proj, t0 + 4 * (tid >> 5), 512 + ((tid & 31) >> 4) * 256 + ((tid & 31) & 15) * 8, rawA);
        conv_rows4_load(proj, t0 + 4 * (tid >> 5), (tid & 31) * 8, rawB);
        const LAS bf16_t* V = (const LAS bf16_t*)(X.lds + hs * 18944); LAS bf16_t* Sm = (LAS bf16_t*)(X.lds + hs * 18944 + 9216);
        const LAS float* sB = (const LAS float*)(X.lds + hs * 18944 + 18432); const LAS float* sI = (const LAS float*)(X.lds + hs * 18944 + 18688);
#pragma unroll
        for (int tt = 0; tt < 2; ++tt) {
            const int t = 32 * rh + 16 * tt + lr, nmax = 2 * rh + tt;
            const float bt = sB[t];
            f32x4 sacc[4], ldv[4]; float mx = -INFINITY;
#pragma unroll
            for (int ni = 0; ni < 4; ++ni) if (ni <= nmax) {
                sacc[ni] = zero4();
#pragma unroll
                for (int ks = 0; ks < 2; ++ks) sacc[ni] = MFMA16(kf[ni][ks], qf[tt][ks], sacc[ni]);
                const f32x4 b4 = *(const LAS f32x4*)(sB + 16 * ni + 4 * lq), i4 = *(const LAS f32x4*)(sI + 16 * ni + 4 * lq);
#pragma unroll
                for (int j = 0; j < 4; ++j) { ldv[ni][j] = (16 * ni + 4 * lq + j <= t) ? (bt - b4[j] + i4[j]) : -INFINITY; mx = fmaxf(mx, ldv[ni][j]); }
            }
            mx = fmaxf(mx, xshfl_f(mx, lane, 16)); mx = fmaxf(mx, xshfl_f(mx, lane, 32));
            const float mt = fmaxf(bt + mc, mx);
#pragma unroll
            for (int ni = 0; ni < 4; ++ni) {
                u32x2 pk = (u32x2){0u, 0u};
                if (ni <= nmax) { float v[4];
#pragma unroll
                    for (int j = 0; j < 4; ++j) v[j] = (16 * ni + 4 * lq + j <= t) ? sacc[ni][j] * 0.125f * __expf(ldv[ni][j] - mt) : 0.0f;
                    pk.x = pk2(v[0], v[1]); pk.y = pk2(v[2], v[3]); }
                *(LAS u32x2*)(Sm + t * 72 + 16 * ni + 4 * lq) = pk;
            }
            const float scl = __expf(bt + mc - mt) * 0.125f, emt = __expf(-mt);
            LDS_WAIT();
            f32x4 num[5];
#pragma unroll
            for (int ei = 0; ei < 5; ++ei) { f32x4 na = zero4(), ca = zero4();
#pragma unroll
                for (int ks = 0; ks < 2; ++ks) {
                    const bf16x8 av = (ei < 4) ? ldT(V + (32 * ks) * 72 + 16 * ei, 72, lane) : ones_frag(lane);
                    na = MFMA16(av, ldN(Sm + (32 * rh + 16 * tt) * 72 + 32 * ks, 72, lane), na);
                    ca = MFMA16(cf[ei][ks], qf[tt][ks], ca); }
                num[ei] = na + ca * scl; }
            const float den = lane_bcast(num[4][0], lr);
            const float inv = 1.0f / fmaxf(fabsf(den), emt);
            float ss = 0.f;
#pragma unroll
            for (int ei = 0; ei < 4; ++ei) { num[ei] = num[ei] * inv; ss += (num[ei][0] * num[ei][0] + num[ei][1] * num[ei][1]) + (num[ei][2] * num[ei][2] + num[ei][3] * num[ei][3]); }
            ss += xshfl_f(ss, lane, 16); ss += xshfl_f(ss, lane, 32);
            const float r = rsqrtf(ss * (1.0f / 64.0f) + EPSN);
#pragma unroll
            for (int ei = 0; ei < 4; ++ei) { const int e0 = 16 * ei + 4 * lq;
                const f32x4 w = *(const f32x4*)(X.mnorm_w + l * 256 + h * 64 + e0);
                const u32x2 mo = *(const u32x2*)(proj + (size_t)(t0 + t) * LDP + PC_MO + h * 64 + e0);
                u32x2 o; o.x = pk2(num[ei][0] * r * w.x * sigmoid_f(bflo(mo.x)), num[ei][1] * r * w.y * sigmoid_f(bfhi(mo.x)));
                o.y = pk2(num[ei][2] * r * w.z * sigmoid_f(bflo(mo.y)), num[ei][3] * r * w.w * sigmoid_f(bfhi(mo.y)));
                *(u32x2*)(mix + (size_t)(t0 + t) * DM + h * 64 + e0) = o; }
        }
        __syncthreads();
    }
    const float* cw = X.conv_w + (size_t)l * 4 * 1024; const float* cb = X.conv_b + (size_t)l * 1024;
#pragma unroll 1
    for (int g = 0; g < 2; ++g) {
        const int tid = opaque_v(X.tid), lane = tid & 63, lr = lane & 15, lq = lane >> 4, h = 4 * g + hs;
        LAS bf16_t* Cm = (LAS bf16_t*)(X.lds);
        LAS bf16_t* Bm = (LAS bf16_t*)(X.lds + 17408);
        LAS float* Gs = (LAS float*)(X.lds + 34816);
        LAS bf16_t* Pm = (LAS bf16_t*)(X.lds + 52224 + hs * 18432);
        LAS bf16_t* Xh = (LAS bf16_t*)(X.lds + 52224 + hs * 18432 + 9216);
        LAS float* sDt = (LAS float*)(X.lds + 125952);
        LAS float* sAc = (LAS float*)(X.lds + 126976);
        LAS float* ssq = (LAS float*)(X.lds + 128000);
        if (wave < 4) {
            const int hh = 4 * g + wave; const float dtb = X.dt_bias[l * 8 + hh], A = -expf(X.a_log[l * 8 + hh]);
            const float dt = softplus_f(gates[(size_t)(t0 + lane) * 32 + 12 + hh] + dtb);
            const float ac = wave_scan_incl(dt * A, lane);
            sDt[wave * 64 + lane] = dt; sAc[wave * 64 + lane] = ac;
        }
        {
            const int rb = tid >> 5, cgp = tid & 31, mat = cgp >> 4, chl = (cgp & 15) * 8;
            float o[4][8]; conv_rows4_apply(rawA, cw, cb, 512 + mat * 256 + g * 128 + chl, o);
#pragma unroll
            for (int r = 0; r < 4; ++r) *(LAS u32x4*)((mat ? Cm : Bm) + (4 * rb + r) * 136 + chl) = pack8(o[r], 1.0f);
        }
        {
            const int rb = tid >> 5, ch = (tid & 31) * 8, sh = ch >> 6;
            float o[4][8]; conv_rows4_apply(rawB, cw, cb, g * 256 + ch, o);
#pragma unroll
            for (int r = 0; r < 4; ++r) *(LAS u32x4*)(X.lds + 52224 + sh * 18432 + 9216 + ((4 * rb + r) * 72 + (ch & 63)) * 2) = pack8(o[r], 1.0f);
        }
        bf16x8 sf[4][4];
        const bf16_t* stg = (const bf16_t*)(X.ws + WS_SST) + (size_t)(c * 8 + h) * 64 * 128;
#pragma unroll
        for (int pi = 0; pi < 4; ++pi)
#pragma unroll
            for (int ks = 0; ks < 4; ++ks) sf[pi][ks] = *(const bf16x8*)(stg + (16 * pi + lr) * 128 + 32 * ks + 8 * lq);
        __syncthreads();
        if (g == 0) {
            conv_rows4_load(proj, t0 + 4 * (tid >> 5), 512 + ((tid & 31) >> 4) * 256 + 128 + ((tid & 31) & 15) * 8, rawA);
            conv_rows4_load(proj, t0 + 4 * (tid >> 5), 256 + (tid & 31) * 8, rawB);
        }
        {
            const int ti = wave >> 1;
#pragma unroll
            for (int sj = 0; sj < 2; ++sj) { const int si = 2 * (wave & 1) + sj; f32x4 acc = zero4();
#pragma unroll
                for (int ks = 0; ks < 4; ++ks) acc = MFMA16(ldN(Bm + 16 * si * 136 + 32 * ks, 136, lane), ldN(Cm + 16 * ti * 136 + 32 * ks, 136, lane), acc);
                *(LAS f32x4*)(Gs + (16 * ti + lr) * 68 + 16 * si + 4 * lq) = acc; }
        }
        __syncthreads();
        const float dsk = X.d_skip[l * 8 + h];
        f32x4 gat[2][4];
#pragma unroll
        for (int tt = 0; tt < 2; ++tt) {
            const int t = 32 * rh + 16 * tt + lr, nmax = 2 * rh + tt;
            const float at = sAc[hs * 64 + t];
#pragma unroll
            for (int ni = 0; ni < 4; ++ni) {
                u32x2 pk = (u32x2){0u, 0u};
                if (ni <= nmax) { const int s0 = 16 * ni + 4 * lq;
                    const f32x4 g4 = *(const LAS f32x4*)(Gs + t * 68 + s0), a4 = *(const LAS f32x4*)(sAc + hs * 64 + s0), d4 = *(const LAS f32x4*)(sDt + hs * 64 + s0);
                    float v[4];
#pragma unroll
                    for (int j = 0; j < 4; ++j) v[j] = (s0 + j <= t) ? g4[j] * __expf(at - a4[j]) * d4[j] : 0.0f;
                    pk.x = pk2(v[0], v[1]); pk.y = pk2(v[2], v[3]); }
                *(LAS u32x2*)(Pm + t * 72 + 16 * ni + 4 * lq) = pk;
            }
            LDS_WAIT();
            const float ea = __expf(at); float ssum = 0.f;
#pragma unroll
            for (int pi = 0; pi < 4; ++pi) { f32x4 ia = zero4(), ie = zero4();
#pragma unroll
                for (int ks = 0; ks < 2; ++ks) ia = MFMA16(ldT(Xh + (32 * ks) * 72 + 16 * pi, 72, lane), ldN(Pm + (32 * rh + 16 * tt) * 72 + 32 * ks, 72, lane), ia);
#pragma unroll
                for (int ks = 0; ks < 4; ++ks) ie = MFMA16(sf[pi][ks], ldN(Cm + (32 * rh + 16 * tt) * 136 + 32 * ks, 136, lane), ie);
                const int p0 = 16 * pi + 4 * lq;
                const u32x2 xw = *(const LAS u32x2*)(Xh + t * 72 + p0);
                const u32x2 zw = *(const u32x2*)(proj + (size_t)(t0 + t) * LDP + PC_SZ + h * 64 + p0);
                const float xv[4] = {bflo(xw.x), bfhi(xw.x), bflo(xw.y), bfhi(xw.y)}, zv[4] = {bflo(zw.x), bfhi(zw.x), bflo(zw.y), bfhi(zw.y)};
#pragma unroll
                for (int j = 0; j < 4; ++j) { const float y = ia[j] + ea * ie[j] + dsk * xv[j]; const float gv = y * zv[j] * sigmoid_f(zv[j]); gat[tt][pi][j] = gv; ssum += gv * gv; }
            }
            ssum += xshfl_f(ssum, lane, 16); ssum += xshfl_f(ssum, lane, 32);
            if (lq == 0) ssq[t * 4 + hs] = ssum;
        }
        __syncthreads();
#pragma unroll
        for (int tt = 0; tt < 2; ++tt) {
            const int t = 32 * rh + 16 * tt + lr;
            const f32x4 q4 = *(const LAS f32x4*)(ssq + t * 4);
            const float r = rsqrtf(((q4.x + q4.y) + (q4.z + q4.w)) * (1.0f / 256.0f) + EPSN);
#pragma unroll
            for (int pi = 0; pi < 4; ++pi) { const int p0 = 16 * pi + 4 * lq;
                const f32x4 w = *(const f32x4*)(X.snorm_w + l * 512 + h * 64 + p0);
                u32x2 o; o.x = pk2(gat[tt][pi][0] * r * w.x, gat[tt][pi][1] * r * w.y); o.y = pk2(gat[tt][pi][2] * r * w.z, gat[tt][pi][3] * r * w.w);
                *(u32x2*)(mix + (size_t)(t0 + t) * DM + 512 + h * 64 + p0) = o; }
        }
        __syncthreads();
    }
}

typedef __bf16 bf16x2_t __attribute__((ext_vector_type(2)));
__device__ __forceinline__ float dot2_bf16(unsigned a, unsigned b, float acc) { return __builtin_amdgcn_fdot2_f32_bf16(__builtin_bit_cast(bf16x2_t, a), __builtin_bit_cast(bf16x2_t, b), acc, false); }
template <int PASS> __device__ __forceinline__ void dsa_attend_head(const Ctx& X, int t_first, int t_stride, int h, u32x4 (&buf)[4][8], const bool primed, const unsigned nextbase) {
    constexpr int NQ = 8, NB = 4 * NQ;
    const int lane = opaque_v(X.lane), g = lane >> 3, c = lane & 7;
    const bf16_t* proj = (const bf16_t*)(X.ws + WS_R1);
    const char* pbase = (const char*)proj;
    const unsigned kbase = (unsigned)(PC_AK + h * 64 + 8 * c) * 2u, vbase = (unsigned)(PC_AV + h * 64 + 8 * c) * 2u;
    const LAS unsigned short* selL = (const LAS unsigned short*)(X.lds + X.wave * 12544);
    LAS unsigned short* pH = (LAS unsigned short*)(X.lds + X.wave * 12544 + 4096);
    const LAS int* nL = (const LAS int*)(X.lds + X.wave * 12544 + 12288);
#define AH_LOAD(slot, bb, basep) do { const int gg_ = opaque_v(g); const u32x4 s_ = *(const LAS u32x4*)(selL + (bb) * 64 + gg_ * 8); \
        const unsigned sw_[4] = {s_.x, s_.y, s_.z, s_.w}; _Pragma("unroll") for (int u = 0; u < 8; ++u) { \
        const unsigned k_ = (u & 1) ? (sw_[u >> 1] >> 16) : (sw_[u >> 1] & 0xffffu); \
        buf[slot][u] = *(const u32x4*)(pbase + (k_ * (unsigned)(LDP * 2) + (basep))); } __builtin_amdgcn_sched_barrier(0); } while (0)
    if (PASS == 0) {
    if (!primed) { AH_LOAD(0, 0, kbase); AH_LOAD(1, 1, kbase); AH_LOAD(2, 2, kbase); }
#pragma unroll 1
    for (int j = 0; j < NQ; ++j) {
        const int t_ = t_first + j * t_stride, t = t_ < SEQ ? t_ : SEQ - 1, nj = nL[j];
        const u32x4 qraw = *(const u32x4*)(proj + (size_t)t * LDP + PC_AQ + h * 64 + 8 * c);
        float lgq[4]; float mxl = -INFINITY;
#pragma unroll
        for (int b = 0; b < 4; ++b) {
            const int bb = 4 * j + b;
            AH_LOAD((b + 3) & 3, (bb + 3 < NB ? bb + 3 : bb + 3 - NB), (bb + 3 < NB ? kbase : nextbase));
            float x[8];
#pragma unroll
            for (int u = 0; u < 8; ++u) x[u] = dot2_bf16(buf[b][u].x, qraw.x, dot2_bf16(buf[b][u].y, qraw.y, dot2_bf16(buf[b][u].z, qraw.z, dot2_bf16(buf[b][u].w, qraw.w, 0.0f))));
#define TR_STEP(HALF, CTRL, BIT) _Pragma("unroll") for (int hh = 0; hh < (HALF); ++hh) { const float lo_ = x[hh], hi_ = x[hh + (HALF)]; \
                const float t1_ = lo_ + DPPF(lo_, CTRL), t2_ = hi_ + DPPF(hi_, CTRL); x[hh] = (c & (BIT)) ? t2_ : t1_; }
            TR_STEP(4, 0x141, 4) TR_STEP(2, 0x4E, 2) TR_STEP(1, 0xB1, 1)
#undef TR_STEP
            const float keep = (64 * b + 8 * c + g < nj) ? x[0] * 0.125f : -INFINITY; lgq[b] = keep; mxl = fmaxf(mxl, keep);
            __builtin_amdgcn_sched_barrier(0);
        }
        const float mx = wave_max(mxl);
        float p[4], sm = 0.f;
#pragma unroll
        for (int b = 0; b < 4; ++b) { p[b] = __expf(lgq[b] - mx); sm += p[b]; }
        const float inv = 1.0f / wave_sum(sm);
#pragma unroll
        for (int b = 0; b < 4; ++b) pH[j * 256 + 64 * b + 8 * g + c] = (unsigned short)f2bf(p[b] * inv);
    }
    LDS_WAIT();
    } else {
    if (!primed) { AH_LOAD(0, 0, vbase); AH_LOAD(1, 1, vbase); AH_LOAD(2, 2, vbase); }
#pragma unroll 1
    for (int j = 0; j < NQ; ++j) {
        const int t_ = t_first + j * t_stride, t = t_ < SEQ ? t_ : SEQ - 1;
        float a[8];
#pragma unroll
        for (int d = 0; d < 8; ++d) a[d] = 0.f;
#pragma unroll
        for (int b = 0; b < 4; ++b) {
            const int bb = 4 * j + b;
            AH_LOAD((b + 3) & 3, (bb + 3 < NB ? bb + 3 : bb + 3 - NB), (bb + 3 < NB ? vbase : nextbase));
            const u32x4 p_ = *(const LAS u32x4*)(pH + j * 256 + 64 * b + 8 * g);
            const unsigned pw[4] = {p_.x, p_.y, p_.z, p_.w};
#pragma unroll
            for (int k = 0; k < 4; ++k) {
                const u32x4 e0 = buf[b][2 * k], e1 = buf[b][2 * k + 1];
                a[0] = dot2_bf16(__builtin_amdgcn_perm(e1.x, e0.x, 0x05040100u), pw[k], a[0]); a[1] = dot2_bf16(__builtin_amdgcn_perm(e1.x, e0.x, 0x07060302u), pw[k], a[1]);
                a[2] = dot2_bf16(__builtin_amdgcn_perm(e1.y, e0.y, 0x05040100u), pw[k], a[2]); a[3] = dot2_bf16(__builtin_amdgcn_perm(e1.y, e0.y, 0x07060302u), pw[k], a[3]);
                a[4] = dot2_bf16(__builtin_amdgcn_perm(e1.z, e0.z, 0x05040100u), pw[k], a[4]); a[5] = dot2_bf16(__builtin_amdgcn_perm(e1.z, e0.z, 0x07060302u), pw[k], a[5]);
                a[6] = dot2_bf16(__builtin_amdgcn_perm(e1.w, e0.w, 0x05040100u), pw[k], a[6]); a[7] = dot2_bf16(__builtin_amdgcn_perm(e1.w, e0.w, 0x07060302u), pw[k], a[7]);
                __builtin_amdgcn_sched_barrier(0); }
        }
#pragma unroll
        for (int d = 0; d < 8; ++d) { a[d] += xshfl_f(a[d], lane, 8); a[d] += xshfl_f(a[d], lane, 16); a[d] += xshfl_f(a[d], lane, 32); }
        if (g == 0) { u32x4 o; o.x = pk2(a[0], a[1]); o.y = pk2(a[2], a[3]); o.z = pk2(a[4], a[5]); o.w = pk2(a[6], a[7]);
            *(LAS u32x4*)(pH + j * 256 + 8 * c) = o; }
    }
    LDS_WAIT();
    {   const int j = lane >> 3; const int t_ = t_first + j * t_stride;
        const u32x4 o = *(const LAS u32x4*)(pH + j * 256 + 8 * c);
        if (t_ < SEQ) *(u32x4*)((bf16_t*)(X.ws + WS_MIX) + (size_t)t_ * DM + 256 + h * 64 + 8 * c) = o; }
    }
#undef AH_LOAD
    LDS_WAIT();
}
__device__ __forceinline__ void dsa_attend_load_sel(const Ctx& X, int t_first, int t_stride) {
    const int lane = X.lane;
    LAS unsigned short* selL = (LAS unsigned short*)(X.lds + X.wave * 12544);
    LAS int* nL = (LAS int*)(X.lds + X.wave * 12544 + 12288);
    unsigned short sv[8][4]; int nn[8];
#pragma unroll
    for (int j = 0; j < 8; ++j) {
        const int t_ = t_first + j * t_stride, t = t_ < SEQ ? t_ : SEQ - 1;
        const unsigned short* srow = (const unsigned short*)(X.ws + WS_SEL) + (size_t)t * 256;
        nn[j] = ((const int*)(X.ws + WS_SMALL))[SM_SELCNT + t];
#pragma unroll
        for (int k = 0; k < 4; ++k) sv[j][k] = srow[lane + 64 * k];
    }
#pragma unroll
    for (int j = 0; j < 8; ++j) {
        const int n = nn[j];
#pragma unroll
        for (int k = 0; k < 4; ++k) { const int i = lane + 64 * k;
            selL[j * 256 + (i & ~63) + (i & 7) * 8 + ((i >> 3) & 7)] = (i < n) ? sv[j][k] : (unsigned short)0; }
        if (lane == 0) nL[j] = n;
    }
    LDS_WAIT();
}

__device__ __forceinline__ void xcd_seam(const Ctx& X) {
    XcdBarrier b_; b_.bar = (unsigned*)(X.ws + WS_CTL) + 1024; b_.x = xb_xcc_id(); b_.st = (volatile LAS unsigned*)(X.lds + LDS_BYTES - 64);
    xcd_local_sync(b_, X.wave == 0 && X.lane == 0);
}
__device__ __forceinline__ void grid_seam(const Ctx& X) {
    XcdBarrier b_; b_.bar = (unsigned*)(X.ws + WS_CTL) + 1024; b_.x = xb_xcc_id(); b_.st = (volatile LAS unsigned*)(X.lds + LDS_BYTES - 64);
    xcd_barrier(b_, X.wave == 0 && X.lane == 0);
}
#ifndef PH_MASK
#define PH_MASK 0x3FF
#endif
#define PH_ON(k) ((PH_MASK >> (k)) & 1)
__device__ __forceinline__ void run_phase(const Ctx& X, int ph) {
    if (ph == 0) { if (PH_ON(9)) p0_prologue(X); return; }
    const int l = (ph - 1) / 9, k = (ph - 1) % 9;
    const bf16_t* H = (const bf16_t*)(X.ws + WS_HX);
    switch (k) {
    case 0: if (PH_ON(0)) {
        pg8::Gemm g{H, (const bf16_t*)(X.ws + WS_WIN), SEQ, NPROJ, 1024}; pg8::StaticOrder S; S.init(SEQ, NPROJ, X.G, X.vb);
        pg8::EpiProj E{(bf16_t*)(X.ws + WS_R1), LDP, (float*)(X.ws + WS_GATES), (const float*)(X.ws + WS_CS), (bf16_t*)(X.ws + WS_IKC)};
        pg8::gemm_phase<pg8::EpiProj, pg8::StaticOrder, true, true>(X.lds, g, S, E, X.wave);
        {
            const int nwg = (SEQ / 256) * (NPROJ / 256), rounds = (nwg + X.G - 1) / X.G, nfull = nwg - (rounds - 1) * X.G;
            if (nfull < X.G && X.vb >= nfull) { asm volatile("s_waitcnt vmcnt(0)" ::: "memory"); __syncthreads(); convert_layer<true>(X, l, CV_IN, CV_ALL, X.vb - nfull, X.G - nfull); }
            else if (nfull >= X.G) { asm volatile("s_waitcnt vmcnt(0)" ::: "memory"); __syncthreads(); convert_layer<true>(X, l, CV_IN, CV_ALL, X.bid, X.G); }
        }
    } break;
    case 1: if (PH_ON(1)) {
#ifndef PROBE_SUB
#define PROBE_SUB 0
#endif
        int first_ = -1;
#ifndef B1_NODSA
        if (opaque_v(X.tid) == 0) first_ = __hip_atomic_fetch_add((int*)(X.ws + WS_CTL + 32768) + l * 64 + opaque_v(0), 1, __ATOMIC_RELAXED, __HIP_MEMORY_SCOPE_AGENT);
#endif
#ifndef B1_NOCHUNK
        for (int r_ = 0; r_ < (PROBE_SUB == 1 ? 2 : 1); ++r_)
        for (int c = X.xmode ? 32 * (X.vb & 7) + (X.vb >> 3) : X.bid; c < 256; c += X.G) b1_chunk(X, l, c);
#endif
#ifndef B1_NODSA
#if PROBE_SUB == 2
        { int* ctr0 = (int*)(X.ws + WS_CTL + 49152); LAS int* nx0 = (LAS int*)(X.lds + IDX_CTL + 14912);
          for (int i = X.bid; i < 512; i += X.G) { dsa_index_item(X, i, ctr0, nx0); dsa_index_item(X, 1023 - i, ctr0, nx0); } }
#endif
        {
            int* ctr = (int*)(X.ws + WS_CTL + 32768) + l * 64;
            LAS int* nxt_ = (LAS int*)(X.lds + IDX_CTL + 14848);
            if (opaque_v(X.tid) == 0) *nxt_ = first_;
            __syncthreads();
            for (;;) {
                int it_ = __builtin_amdgcn_readfirstlane(*nxt_);
                if (it_ < 0) {
                    __syncthreads();
                    if (opaque_v(X.tid) == 0) *nxt_ = __hip_atomic_fetch_add(ctr, 1, __ATOMIC_RELAXED, __HIP_MEMORY_SCOPE_AGENT);
                    __syncthreads();
                    it_ = __builtin_amdgcn_readfirstlane(*nxt_);
                }
                if (it_ >= 1024) break;
                dsa_index_item(X, 1023 - it_, ctr, nxt_);
            }
        }
#endif
    } break;
    case 2: if (PH_ON(2)) b2_scan(X); break;
    case 3: if (PH_ON(3)) {
#ifndef B3_NOCHUNK
        for (int r_ = 0; r_ < (PROBE_SUB == 3 ? 2 : 1); ++r_)
        for (int c = X.xmode ? 32 * (X.vb & 7) + (X.vb >> 3) : X.bid; c < 256; c += X.G) b3_chunk(X, l, c);
#endif
#ifndef B3_NOATT
        for (int r_ = 0; r_ < (PROBE_SUB == 4 ? 2 : 1); ++r_)
        {
            const int gw = X.xmode ? 2048 * (X.vb & 7) + 8 * (X.vb >> 3) + X.wave : X.bid * NWAVES + X.wave, NGW = X.xmode ? 256 : X.G * NWAVES;
            dsa_attend_load_sel(X, gw, NGW);
#ifndef ATT_SEAMS
#define ATT_SEAMS 0
#endif
            u32x4 abuf[4][8];
            const unsigned cl2 = (unsigned)(8 * (opaque_v(X.lane) & 7)) * 2u;
            for (int h = 0; h < 4; ++h) {
                const unsigned vb_ = (unsigned)(PC_AV + h * 64) * 2u + cl2, kn_ = (unsigned)(PC_AK + (h < 3 ? h + 1 : h) * 64) * 2u + cl2;
                dsa_attend_head<0>(X, gw, NGW, h, abuf, h > 0, vb_); if (ATT_SEAMS & 1) xcd_seam(X);
                dsa_attend_head<1>(X, gw, NGW, h, abuf, true, kn_); if (h < 3 && (ATT_SEAMS & 2)) xcd_seam(X); }
        }
#endif
    } break;
    case 4: if (PH_ON(4)) {
        pg8::Gemm g{(const bf16_t*)(X.ws + WS_MIX), (const bf16_t*)(X.ws + WS_WOUT), SEQ, 1024, 1024}; pg8::StaticOrder S; S.init(SEQ, 1024, X.G, X.vb);
        pg8::PanelSS st{(float*)(X.ws + WS_PSS), (unsigned*)(X.ws + WS_CTL + 36864), SEQ, EPSN, 1.0f / DM};
        pg8::EpiRmsRes<false> E{(const bf16_t*)X.out, 2 * DM, (void*)(X.ws + WS_SST), DM, (bf16_t*)(X.ws + WS_HX), X.norm_w + (size_t)(l * 4 + 1) * DM, X.norm_w + (size_t)(l * 4 + 2) * DM, st, 4 * l};
        pg8::gemm_phase<pg8::EpiRmsRes<false>, pg8::StaticOrder, true, true>(X.lds, g, S, E, X.wave);
    } break;
    case 5: if (false) {
        if (l == 0) norm_phase<true, false>(X, (const bf16_t*)(X.ws + WS_R1), X.x_in, X.norm_w + (size_t)(l * 4 + 1) * DM, X.norm_w + (size_t)(l * 4 + 2) * DM);
        else        norm_phase<false, false>(X, (const bf16_t*)(X.ws + WS_R1), X.out, X.norm_w + (size_t)(l * 4 + 1) * DM, X.norm_w + (size_t)(l * 4 + 2) * DM);
    } break;
    case 6: if (PH_ON(6)) {
        pg8::Gemm g{H, (const bf16_t*)(X.ws + WS_WGU), SEQ, 2 * DFF, 1024}; pg8::StaticOrder S; S.init(SEQ, 2 * DFF, X.G, X.vb);
        pg8::EpiSwiGLU E{(bf16_t*)(X.ws + WS_R1), DFF};
        pg8::gemm_phase<pg8::EpiSwiGLU, pg8::StaticOrder, true, true>(X.lds, g, S, E, X.wave);
        if (l + 1 < NLAYER) {
            const int nwg = (SEQ / 256) * (2 * DFF / 256), rounds = (nwg + X.G - 1) / X.G, nfull = nwg - (rounds - 1) * X.G;
            if (nfull < X.G && X.vb >= nfull) { asm volatile("s_waitcnt vmcnt(0)" ::: "memory"); __syncthreads(); convert_layer<true>(X, l + 1, 0, CV_IN, X.vb - nfull, X.G - nfull); }
            else if (nfull >= X.G) { asm volatile("s_waitcnt vmcnt(0)" ::: "memory"); __syncthreads(); convert_layer<true>(X, l + 1, 0, CV_IN, X.bid, X.G); }
        }
    } break;
    case 7: if (PH_ON(7)) {
        pg8::Gemm g{(const bf16_t*)(X.ws + WS_R1), (const bf16_t*)(X.ws + ((l & 1) ? WS_WDN2 : WS_WDN)), SEQ, 1024, DFF}; pg8::StaticOrder S; S.init(SEQ, 1024, X.G, X.vb);
        pg8::PanelSS st{(float*)(X.ws + WS_PSS), (unsigned*)(X.ws + WS_CTL + 36864), SEQ, EPSN, 1.0f / DM};
        if (l + 1 < NLAYER) {
            pg8::EpiRmsRes<false> E{(const bf16_t*)(X.ws + WS_SST), DM, (void*)X.out, 2 * DM, (bf16_t*)(X.ws + WS_HX), X.norm_w + (size_t)(l * 4 + 3) * DM, X.norm_w + (size_t)((l + 1) * 4) * DM, st, 4 * l + 2};
            pg8::gemm_phase<pg8::EpiRmsRes<false>, pg8::StaticOrder, true, true>(X.lds, g, S, E, X.wave);
        } else {
            pg8::EpiRmsRes<true> E{(const bf16_t*)(X.ws + WS_SST), DM, (void*)X.out, DM, nullptr, X.norm_w + (size_t)(l * 4 + 3) * DM, nullptr, st, 4 * l + 2};
            pg8::gemm_phase<pg8::EpiRmsRes<true>, pg8::StaticOrder, true, true>(X.lds, g, S, E, X.wave);
        }
    } break;
    default: if (false) {
        if (l + 1 < NLAYER) norm_phase<false, false>(X, (const bf16_t*)(X.ws + WS_R2), X.out, X.norm_w + (size_t)(l * 4 + 3) * DM, X.norm_w + (size_t)((l + 1) * 4) * DM);
        else                norm_phase<false, true>(X, (const bf16_t*)(X.ws + WS_R2), X.out, X.norm_w + (size_t)(l * 4 + 3) * DM, nullptr);
        if (l + 1 < NLAYER) convert_layer(X, l + 1, CV_GU, CV_ALL, X.bid, X.G);
    } break;
    }
}

struct Args { const void* in[16]; float* out; unsigned char* ws; int ph_lo, ph_hi; };
__global__ void __launch_bounds__(NTHR, 2) hyb_fwd(Args a) {
    extern __shared__ __attribute__((aligned(16))) unsigned char lds_raw[];
    Ctx X;
    X.lds = (LAS unsigned char*)lds_raw; X.G = gridDim.x; X.bid = blockIdx.x; X.vb = blockIdx.x; X.xmode = 0; X.wave = __builtin_amdgcn_readfirstlane((int)threadIdx.x >> 6);
    const int ph_lo = a.ph_lo, ph_hi = a.ph_hi;
#if !MK_MULTI
    volatile LAS unsigned* bst = (volatile LAS unsigned*)((LAS unsigned char*)lds_raw + LDS_BYTES - 64);
    if (threadIdx.x < 4) bst[threadIdx.x] = 0u;
    __syncthreads();
    (void)xcd_barrier_post((unsigned*)(a.ws + WS_CTL) + 1024, bst, threadIdx.x == 0);
#define GRID_SEAM(first) do { if (ph_lo < 0) cg::this_grid().sync();     \
        { XcdBarrier b_; b_.bar = (unsigned*)(X.ws + WS_CTL) + 1024; b_.x = xb_xcc_id(); \
        b_.st = (volatile LAS unsigned*)((LAS unsigned char*)lds_raw + LDS_BYTES - 64); xcd_barrier(b_, X.wave == 0 && X.lane == 0, X.wave == 1, !(first), norel_); } } while (0)
#else
#define GRID_SEAM(first) do { } while (0)
#endif
    bool norel_ = false;
#pragma unroll 1
    for (int ph = ph_lo; ph < ph_hi; ++ph) {
        { int l_; asm volatile("v_mbcnt_lo_u32_b32 %0, -1, 0\n\tv_mbcnt_hi_u32_b32 %0, -1, %0" : "=v"(l_)); X.lane = l_; X.tid = l_ + 64 * X.wave; }
#if !MK_MULTI
        if (ph > ph_lo) {
            const volatile LAS unsigned* bs_ = (const volatile LAS unsigned*)((LAS unsigned char*)lds_raw + LDS_BYTES - 64);
            const int even_ = (int)__builtin_amdgcn_readfirstlane((int)bs_[3]), rank_ = (int)__builtin_amdgcn_readfirstlane((int)bs_[2]);
#ifdef FORCE_NOX
            X.xmode = (even_ != 0 && X.G == 257) ? 1 : 0;
#else
            X.xmode = (even_ != 0 && X.G == 256) ? 1 : 0;
#endif
            X.vb = X.xmode ? rank_ * 8 + (int)xb_xcc_id() : X.bid;
        }
#endif
        {
            const __attribute__((address_space(4))) Args* k = (const __attribute__((address_space(4))) Args*)__builtin_amdgcn_kernarg_segment_ptr();
            asm volatile("" : "+s"(k));
            X.x_in = (const float*)k->in[0]; X.pos = (const int*)k->in[1]; X.norm_w = (const float*)k->in[2]; X.w_in = (const float*)k->in[3]; X.gate_b = (const float*)k->in[4];
            X.mnorm_w = (const float*)k->in[5]; X.conv_w = (const float*)k->in[6]; X.conv_b = (const float*)k->in[7]; X.dt_bias = (const float*)k->in[8]; X.a_log = (const float*)k->in[9];
            X.d_skip = (const float*)k->in[10]; X.snorm_w = (const float*)k->in[11]; X.w_out = (const float*)k->in[12]; X.w_gate = (const float*)k->in[13]; X.w_up = (const float*)k->in[14]; X.w_down = (const float*)k->in[15];
            X.out = k->out; X.ws = k->ws;
        }
#if defined(PROBE_KIND)
        {
            const int reps_ = (ph > 0 && ((ph - 1) % 9) == PROBE_KIND) ? PROBE_REPS : 1;
            for (int r_ = 1; r_ < reps_; ++r_) { run_phase(X, ph); GRID_SEAM(false); }
        }
#endif
        if (ph > 0 && (((ph - 1) % 9) == 5 || ((ph - 1) % 9) == 8)) continue;
        run_phase(X, ph);
#if !MK_MULTI && !defined(NO_LOCAL_SEAMS)
        if (ph + 1 < ph_hi && X.xmode && ph > 0 && (((ph - 1) % 9) == 3 || ((ph - 1) % 9) == 4 || ((ph - 1) % 9) == 6)) {
            XcdBarrier b_; b_.bar = (unsigned*)(X.ws + WS_CTL) + 1024; b_.x = xb_xcc_id(); b_.st = (volatile LAS unsigned*)((LAS unsigned char*)lds_raw + LDS_BYTES - 64);
            xcd_local_seam(b_, X.wave == 0 && X.lane == 0, X.wave == 1, true);
            continue;
        }
#endif
        norel_ = X.xmode && ph > 0 && (((ph - 1) % 9) == 7 || ((ph - 1) % 9) == 0);
        if (ph + 1 < ph_hi) GRID_SEAM(ph == ph_lo);
    }
}

extern "C" void kernel_launch(void* const* d_in, const int* in_sizes, int n_in, void* d_out, int out_size, void* d_ws, size_t ws_size, hipStream_t stream) {
    static int grid = 0;
    if (grid == 0) {
        if (n_in != 16 || out_size != SEQ * DM || ws_size < WS_END) { fprintf(stderr, "kernel_launch: unexpected shapes (n_in %d out %d ws %zu)\n", n_in, out_size, ws_size); grid = -1; return; }
        int dev = 0, cus = 0, per_cu = 0;
        if (hipGetDevice(&dev) != hipSuccess || hipDeviceGetAttribute(&cus, hipDeviceAttributeMultiprocessorCount, dev) != hipSuccess) { grid = -1; return; }
        if (hipFuncSetAttribute((const void*)hyb_fwd, hipFuncAttributeMaxDynamicSharedMemorySize, LDS_BYTES) != hipSuccess) { fprintf(stderr, "kernel_launch: hipFuncSetAttribute failed\n"); grid = -1; return; }
        if (hipOccupancyMaxActiveBlocksPerMultiprocessor(&per_cu, (const void*)hyb_fwd, NTHR, LDS_BYTES) != hipSuccess || per_cu < 1) { fprintf(stderr, "kernel_launch: occupancy query says %d\n", per_cu); per_cu = 1; }
        (void)hipGetLastError();
        grid = cus * 1;
        if (grid > 256) grid = 256;
    }
    if (grid < 0) return;
    if (hipMemsetAsync((char*)d_ws + WS_CTL, 0, 65536, stream) != hipSuccess) { fprintf(stderr, "kernel_launch: memset of the control words failed\n"); return; }
    Args a{};
    for (int i = 0; i < 16; ++i) a.in[i] = d_in[i];
    a.out = (float*)d_out; a.ws = (unsigned char*)d_ws;
#if MK_MULTI
    for (int ph = 0; ph < NPH; ++ph) { a.ph_lo = ph; a.ph_hi = ph + 1; hipLaunchKernelGGL(hyb_fwd, dim3(grid), dim3(NTHR), LDS_BYTES, stream, a); }
#else
    a.ph_lo = 0; a.ph_hi = NPH - 1;
    void* args[] = {&a};
    hipError_t e = hipLaunchCooperativeKernel((const void*)hyb_fwd, dim3(grid), dim3(NTHR), args, LDS_BYTES, stream);
    if (e != hipSuccess) fprintf(stderr, "kernel_launch: cooperative launch failed: %s (grid %d)\n", hipGetErrorString(e), grid);
#endif
}
```
